# Optimizing an MI355X kernel written in HIP

```python
import jax, jax.numpy as jnp
from jax import lax
import numpy as np

D_MODEL = 1024
BATCH = 8
SEQ = 2048
DEPTH = 2

GRID_W = 64
CTX_LEN = 256
D_MIX = D_MODEL
MLA_HEADS = 8
MLA_NOPE = 64
MLA_ROPE = 32
MLA_V = 64
MLA_QK = MLA_NOPE + MLA_ROPE
MLA_WIDTH = MLA_HEADS * MLA_V
Q_LORA = 256
KV_LORA = 128
Q_BLOCK = 128
RET_HEADS = 4
RET_DK = 64
RET_DV = 64
RET_WIDTH = RET_HEADS * RET_DV
RET_CHUNK = 128
CONV_WIDTH = D_MIX - MLA_WIDTH - RET_WIDTH
CONV_K = 31

ROPE_BASE = 10000.0
EPS = 1e-5
ALPHA = (2 * DEPTH) ** 0.25
BETA = (8 * DEPTH) ** -0.25

IN_SIZES = (Q_LORA, KV_LORA, MLA_ROPE, MLA_WIDTH,
            RET_HEADS * RET_DK, RET_HEADS * RET_DK, RET_WIDTH, RET_WIDTH,
            2 * CONV_WIDTH, CONV_WIDTH)
IN_COLS = sum(IN_SIZES)

kernel_name = 'hybrid_mla_retention_conformer_dit'


def _split_cols(p):
    offs, s = [], 0
    for n in IN_SIZES[:-1]:
        s += n
        offs.append(s)
    return jnp.split(p, offs, axis=-1)


def _standardize(x):
    xf = x.astype(jnp.float32)
    mu = jnp.mean(xf, axis=-1, keepdims=True)
    var = jnp.mean(jnp.square(xf - mu), axis=-1, keepdims=True)
    return ((xf - mu) * lax.rsqrt(var + EPS)).astype(x.dtype)


def _layer_norm(x, g, b):
    xf = x.astype(jnp.float32)
    mu = jnp.mean(xf, axis=-1, keepdims=True)
    var = jnp.mean(jnp.square(xf - mu), axis=-1, keepdims=True)
    y = (xf - mu) * lax.rsqrt(var + EPS) * g.astype(jnp.float32) + b.astype(jnp.float32)
    return y.astype(x.dtype)


def _rms_norm(x, g):
    xf = x.astype(jnp.float32)
    y = xf * lax.rsqrt(jnp.mean(jnp.square(xf), axis=-1, keepdims=True) + EPS) * g.astype(jnp.float32)
    return y.astype(x.dtype)


def _rotate(x, pos):
    d2 = x.shape[-1]
    inv = ROPE_BASE ** (-jnp.arange(0, d2, 2, dtype=jnp.float32) / d2)
    ang = pos.astype(jnp.float32)[:, None] * inv[None, :]
    cos = jnp.cos(ang)[:, None, :].astype(x.dtype)
    sin = jnp.sin(ang)[:, None, :].astype(x.dtype)
    x1, x2 = jnp.split(x, 2, axis=-1)
    return jnp.concatenate([x1 * cos - x2 * sin, x1 * sin + x2 * cos], axis=-1)


def _axial_rope(x, row, col):
    half = x.shape[-1] // 2
    return jnp.concatenate([_rotate(x[..., :half], row), _rotate(x[..., half:], col)], axis=-1)


def _block_attention(q, k, v):
    B, L, H, dqk = q.shape
    nb = L // Q_BLOCK
    scale = dqk ** -0.5
    qb = q.reshape(B, nb, Q_BLOCK, H, dqk).transpose(1, 0, 2, 3, 4)

    def one_block(qi):
        s = jnp.einsum('bqhd,bkhd->bhqk', qi, k).astype(jnp.float32) * scale
        p = jax.nn.softmax(s, axis=-1).astype(v.dtype)
        return jnp.einsum('bhqk,bkhe->bqhe', p, v)

    o = lax.map(one_block, qb)
    return o.transpose(1, 0, 2, 3, 4).reshape(B, L, H * v.shape[-1])


def _mla_q(p_q, g_q, w_uq, row, col):
    B, L, _ = p_q.shape
    q = (_rms_norm(p_q, g_q) @ w_uq).reshape(B, L, MLA_HEADS, MLA_QK)
    q_nope, q_rope = q[..., :MLA_NOPE], q[..., MLA_NOPE:]
    if row is not None:
        q_rope = _axial_rope(q_rope, row, col)
    return jnp.concatenate([q_nope, q_rope], axis=-1)


def _mla_kv(p_kv, p_kr, g_kv, w_ukv, row, col):
    B, L, _ = p_kv.shape
    kv = (_rms_norm(p_kv, g_kv) @ w_ukv).reshape(B, L, MLA_HEADS, MLA_NOPE + MLA_V)
    k_nope, v = kv[..., :MLA_NOPE], kv[..., MLA_NOPE:]
    k_rope = p_kr[:, :, None, :]
    if row is not None:
        k_rope = _axial_rope(k_rope, row, col)
    k = jnp.concatenate([k_nope, jnp.broadcast_to(k_rope, (B, L, MLA_HEADS, MLA_ROPE))], axis=-1)
    return k, v


def _ret_qkv(p_q, p_k, p_v, row, col):
    B, L, _ = p_q.shape
    q = p_q.reshape(B, L, RET_HEADS, RET_DK)
    k = p_k.reshape(B, L, RET_HEADS, RET_DK) * (RET_DK ** -0.5)
    v = p_v.reshape(B, L, RET_HEADS, RET_DV)
    if row is not None:
        q = _axial_rope(q, row, col)
        k = _axial_rope(k, row, col)
    to_bhld = lambda t: t.transpose(0, 2, 1, 3).astype(jnp.float32)
    return to_bhld(q), to_bhld(k), to_bhld(v)


def _retention_chunks(q, k, v, log_gamma, s0, strict):
    B, H, L, dk = q.shape
    dv = v.shape[-1]
    n = L // RET_CHUNK
    idx = jnp.arange(RET_CHUNK, dtype=jnp.float32)
    diff = idx[:, None] - idx[None, :]
    lg = log_gamma[:, None, None]
    mask = (diff > 0) if strict else (diff >= 0)
    dmat = jnp.where(mask, jnp.exp(lg * jnp.maximum(diff, 0.0)), 0.0)
    q_dec = jnp.exp(lg * (idx[None, :, None] + 1.0))
    k_dec = jnp.exp(lg * (RET_CHUNK - 1.0 - idx)[None, :, None])
    c_dec = jnp.exp(log_gamma * RET_CHUNK)[:, None, None]

    def chunked(t):
        return t.reshape(B, H, n, RET_CHUNK, t.shape[-1]).transpose(2, 0, 1, 3, 4)

    def step(state, qkv):
        qi, ki, vi = qkv
        inner = jnp.einsum('bhij,bhje->bhie', jnp.einsum('bhid,bhjd->bhij', qi, ki) * dmat, vi)
        cross = jnp.einsum('bhid,bhde->bhie', qi * q_dec, state)
        state = state * c_dec + jnp.einsum('bhjd,bhje->bhde', ki * k_dec, vi)
        return state, inner + cross

    s_fin, o = lax.scan(step, s0, (chunked(q), chunked(k), chunked(v)))
    return o.transpose(1, 2, 0, 3, 4).reshape(B, H, L, dv), s_fin


def _ret_out(o, gate, g, b):
    B, H, L, dv = o.shape
    of = o.transpose(0, 2, 1, 3)
    mu = jnp.mean(of, axis=-1, keepdims=True)
    var = jnp.mean(jnp.square(of - mu), axis=-1, keepdims=True)
    y = ((of - mu) * lax.rsqrt(var + EPS)).reshape(B, L, H * dv)
    y = y * g.astype(jnp.float32) + b.astype(jnp.float32)
    return y.astype(gate.dtype) * jax.nn.silu(gate)


def _conformer_conv(p_glu, p_gate, dw, dw_b, ln_g, ln_b, pw, pw_b):
    a, g = jnp.split(p_glu, 2, axis=-1)
    u = a * jax.nn.sigmoid(g)
    y = lax.conv_general_dilated(u, dw[:, None, :], window_strides=(1,),
                                 padding=[(CONV_K // 2, CONV_K // 2)],
                                 dimension_numbers=('NWC', 'WIO', 'NWC'),
                                 feature_group_count=CONV_WIDTH) + dw_b
    y = jax.nn.silu(_layer_norm(y, ln_g, ln_b))
    y = y @ pw + pw_b
    return y * jax.nn.silu(p_gate)


def _layer(x, hc, c, c_ctx, w_mod, b_mod, w_in, g_q, w_uq, g_kv, w_ukv, dec_f, dec_b, gn_g, gn_b,
           dw, dw_b, cln_g, cln_b, pw, pw_b, w_out, ln_g, ln_b, row, col, need_ctx):
    B = x.shape[0]
    shift, scale, gate = jnp.split(jax.nn.silu(c) @ w_mod + b_mod, 3, axis=-1)
    shift_c, scale_c, gate_c = jnp.split(jax.nn.silu(c_ctx) @ w_mod + b_mod, 3, axis=-1)
    u = _standardize(x) * (1 + scale[:, None]) + shift[:, None]
    uc = _standardize(hc) * (1 + scale_c) + shift_c
    (pq, pkv, pkr, pg_mla, prq, prk, prv, pg_ret, pglu, pg_conv) = _split_cols(u @ w_in)
    (cq, ckv, ckr, cg_mla, crq, crk, crv, cg_ret, cglu, cg_conv) = _split_cols(uc @ w_in)

    kc, vc = _mla_kv(ckv, ckr, g_kv, w_ukv, None, None)
    k, v = _mla_kv(pkv, pkr, g_kv, w_ukv, row, col)
    q = _mla_q(pq, g_q, w_uq, row, col)
    o_mla = _block_attention(q, jnp.concatenate([kc, k], axis=1),
                             jnp.concatenate([vc, v], axis=1)) * jax.nn.silu(pg_mla)

    qc_r, kc_r, vc_r = _ret_qkv(crq, crk, crv, None, None)
    q_r, k_r, v_r = _ret_qkv(prq, prk, prv, row, col)
    lg_f = jax.nn.log_sigmoid(dec_f.astype(jnp.float32))
    lg_b = jax.nn.log_sigmoid(dec_b.astype(jnp.float32))
    zero = jnp.zeros((B, RET_HEADS, RET_DK, RET_DV), jnp.float32)
    fl = lambda t: jnp.flip(t, axis=2)
    oc_f, sc_f = _retention_chunks(qc_r, kc_r, vc_r, lg_f, zero, False)
    oc_b, sc_b = _retention_chunks(fl(qc_r), fl(kc_r), fl(vc_r), lg_b, zero, True)
    o_f, _ = _retention_chunks(q_r, k_r, v_r, lg_f, sc_f, False)
    o_b, _ = _retention_chunks(fl(q_r), fl(k_r), fl(v_r), lg_b, sc_b, True)
    o_ret = _ret_out(o_f + fl(o_b), pg_ret, gn_g, gn_b)

    o_conv = _conformer_conv(pglu, pg_conv, dw, dw_b, cln_g, cln_b, pw, pw_b)

    y = jnp.concatenate([o_mla, o_ret, o_conv], axis=-1) @ w_out
    x_new = _layer_norm(ALPHA * x + gate[:, None] * y, ln_g, ln_b)
    if not need_ctx:
        return x_new, None

    qc = _mla_q(cq, g_q, w_uq, None, None)
    oc_mla = _block_attention(qc, kc, vc) * jax.nn.silu(cg_mla)
    oc_ret = _ret_out(oc_f + fl(oc_b), cg_ret, gn_g, gn_b)
    oc_conv = _conformer_conv(cglu, cg_conv, dw, dw_b, cln_g, cln_b, pw, pw_b)
    yc = jnp.concatenate([oc_mla, oc_ret, oc_conv], axis=-1) @ w_out
    hc_new = _layer_norm(ALPHA * hc + gate_c * yc, ln_g, ln_b)
    return x_new, hc_new


def setup_inputs(seed: int = 0) -> dict:
    key = jax.random.key(seed)
    ks = jax.random.split(key, 24)
    f32 = jnp.float32
    nrm = lambda k, shape, s: jax.random.normal(k, shape, f32) * s
    gam = 1.0 - 2.0 ** (-5.0 - jnp.arange(RET_HEADS, dtype=f32))
    logit = jnp.log(gam) - jnp.log1p(-gam)
    return {
        'x': nrm(ks[0], (BATCH, SEQ, D_MODEL), 1.0),
        'c': nrm(ks[1], (BATCH, D_MODEL), 1.0),
        'ctx': nrm(ks[2], (BATCH, CTX_LEN, D_MODEL), 1.0),
        'c_ctx': nrm(ks[3], (D_MODEL,), 1.0),
        'w_mod': nrm(ks[4], (DEPTH, D_MODEL, 3 * D_MODEL), D_MODEL ** -0.5),
        'b_mod': nrm(ks[5], (DEPTH, 3 * D_MODEL), 0.02),
        'w_in': nrm(ks[6], (DEPTH, D_MODEL, IN_COLS), D_MODEL ** -0.5),
        'mla_q_norm': 1.0 + nrm(ks[7], (DEPTH, Q_LORA), 0.02),
        'w_uq': nrm(ks[8], (DEPTH, Q_LORA, MLA_HEADS * MLA_QK), Q_LORA ** -0.5),
        'mla_kv_norm': 1.0 + nrm(ks[9], (DEPTH, KV_LORA), 0.02),
        'w_ukv': nrm(ks[10], (DEPTH, KV_LORA, MLA_HEADS * (MLA_NOPE + MLA_V)), KV_LORA ** -0.5),
        'ret_decay_fwd': logit[None, :] + nrm(ks[11], (DEPTH, RET_HEADS), 0.1),
        'ret_decay_bwd': logit[None, :] + nrm(ks[12], (DEPTH, RET_HEADS), 0.1),
        'ret_gn_g': 1.0 + nrm(ks[13], (DEPTH, RET_WIDTH), 0.02),
        'ret_gn_b': nrm(ks[14], (DEPTH, RET_WIDTH), 0.02),
        'conv_dw': nrm(ks[15], (DEPTH, CONV_K, CONV_WIDTH), CONV_K ** -0.5),
        'conv_dw_b': nrm(ks[16], (DEPTH, CONV_WIDTH), 0.02),
        'conv_ln_g': 1.0 + nrm(ks[17], (DEPTH, CONV_WIDTH), 0.02),
        'conv_ln_b': nrm(ks[18], (DEPTH, CONV_WIDTH), 0.02),
        'conv_pw': nrm(ks[19], (DEPTH, CONV_WIDTH, CONV_WIDTH), CONV_WIDTH ** -0.5),
        'conv_pw_b': nrm(ks[20], (DEPTH, CONV_WIDTH), 0.02),
        'w_out': nrm(ks[21], (DEPTH, D_MIX, D_MODEL), BETA * D_MIX ** -0.5),
        'ln_g': 1.0 + nrm(ks[22], (DEPTH, D_MODEL), 0.02),
        'ln_b': nrm(ks[23], (DEPTH, D_MODEL), 0.02),
    }


def reference(x, c, ctx, c_ctx, w_mod, b_mod, w_in, mla_q_norm, w_uq, mla_kv_norm, w_ukv,
              ret_decay_fwd, ret_decay_bwd, ret_gn_g, ret_gn_b, conv_dw, conv_dw_b, conv_ln_g, conv_ln_b,
              conv_pw, conv_pw_b, w_out, ln_g, ln_b):
    L = x.shape[1]
    ROWS = L // GRID_W
    row = jnp.broadcast_to(jnp.arange(ROWS, dtype=jnp.int32)[:, None], (ROWS, GRID_W)).reshape(-1)
    col = jnp.broadcast_to(jnp.arange(GRID_W, dtype=jnp.int32)[None, :], (ROWS, GRID_W)).reshape(-1)
    hc = ctx
    for l in range(DEPTH):
        x, hc = _layer(x, hc, c, c_ctx, w_mod[l], b_mod[l], w_in[l], mla_q_norm[l], w_uq[l],
                       mla_kv_norm[l], w_ukv[l], ret_decay_fwd[l], ret_decay_bwd[l], ret_gn_g[l], ret_gn_b[l],
                       conv_dw[l], conv_dw_b[l], conv_ln_g[l], conv_ln_b[l], conv_pw[l], conv_pw_b[l],
                       w_out[l], ln_g[l], ln_b[l], row, col, l < DEPTH - 1)
    return x
```

```cpp
#include <hip/hip_runtime.h>
#include <hip/hip_cooperative_groups.h>
#include <cstdio>
#include <cstdint>
namespace cg = cooperative_groups;

#ifndef ONE_LAUNCH
#define ONE_LAUNCH 1
#endif

typedef unsigned short bfraw;
typedef __attribute__((ext_vector_type(8))) __bf16 bf16x8;
typedef __attribute__((ext_vector_type(16))) float f32x16;

#define DM 1024
#define NB 8
#define SEQ 2048
#define CTX 256
#define NLAT (NB * SEQ)
#define NCTX (NB * CTX)
#define NROW (NLAT + NCTX)
#define INC 2720
#define INCP 2816
#define LKEYS 2304
#define C_PQ 0
#define C_PKV 256
#define C_PKR 384
#define C_GMLA 416
#define C_RQ 928
#define C_RK 1184
#define C_RV 1440
#define C_GRET 1696
#define C_GLU 1952
#define C_GCONV 2464
#define NCHUNK 18
#define EPSF 1e-5f
#define ALPHA_F 1.4142135623730951f
#define NPHASE 12
#define DYN_LDS (16 + 31744 + 32768)

struct Params {
  const float *x, *c, *ctx, *c_ctx, *w_mod, *b_mod, *w_in, *g_q, *w_uq, *g_kv, *w_ukv, *dec_f, *dec_b, *gn_g, *gn_b,
      *dw, *dw_b, *cln_g, *cln_b, *pw, *pw_b, *w_out, *ln_g, *ln_b;
  float* out;
  bfraw *wt_in, *wt_uq, *wt_ukv, *wt_pw, *wt_out;
  float* mod;
  float2* tabA;
  float2* tabB;
  bfraw* U;
  bfraw* P;
  bfraw *Q, *KN, *VT;
  float* CST;
  float* HC1;
  unsigned* bar;
  bfraw* KR;
  bfraw* PRE;
  int phase_begin, phase_end;
};

typedef __attribute__((ext_vector_type(2))) float f2v;
typedef __attribute__((ext_vector_type(2))) __bf16 bf2v;
__device__ __forceinline__ unsigned pack2(float a, float b) {
  f2v v = {a, b};
  bf2v r = __builtin_convertvector(v, bf2v);
  return __builtin_bit_cast(unsigned, r);
}
__device__ __forceinline__ bfraw f2bf(float f) { return (bfraw)(pack2(f, 0.f) & 0xffffu); }
__device__ __forceinline__ float bf2f(bfraw b) { return __uint_as_float(((unsigned)b) << 16); }
__device__ __forceinline__ float lo_bf(unsigned u) { return __uint_as_float(u << 16); }
__device__ __forceinline__ float hi_bf(unsigned u) { return __uint_as_float(u & 0xffff0000u); }
__device__ __forceinline__ float siluf(float x) { return x * __builtin_amdgcn_rcpf(1.0f + __expf(-x)); }
__device__ __forceinline__ float sigmf(float x) { return __builtin_amdgcn_rcpf(1.0f + __expf(-x)); }

__device__ __forceinline__ int otid() {
  int t = threadIdx.x;
  asm volatile("" : "+v"(t));
  return t;
}

union Frag {
  bf16x8 v;
  uint4 u;
  uint2 d[2];
  unsigned w[4];
};

__device__ __forceinline__ f32x16 mfma32(const Frag& a, const Frag& b, f32x16 c) {
  return __builtin_amdgcn_mfma_f32_32x32x16_bf16(a.v, b.v, c, 0, 0, 0);
}
__device__ __forceinline__ f32x16 zero16() {
  f32x16 z;
#pragma unroll
  for (int i = 0; i < 16; ++i) z[i] = 0.f;
  return z;
}
__device__ __forceinline__ float wave_sum(float v) {
#pragma unroll
  for (int o = 32; o > 0; o >>= 1) v += __shfl_xor(v, o);
  return v;
}

#define XB_TMO      128
#define XB_XCNT(j)  (256  + 64 * (j))
#define XB_XSUB(j)  (1280 + 64 * (j))
#define XB_XGEN(j)  (2304 + 64 * (j))
#define XB_TOP      3328
#define XB_TOPGEN   3392
#define XCD_BAR_WORDS 3456
#define XB_SPIN_CAP (1u << 22)
#define LAS __attribute__((address_space(3)))
__device__ __forceinline__ unsigned xb_ld(unsigned* p) { return __hip_atomic_load(p, __ATOMIC_RELAXED, __HIP_MEMORY_SCOPE_AGENT); }
__device__ __forceinline__ unsigned xb_add(unsigned* p, unsigned v) { return __hip_atomic_fetch_add(p, v, __ATOMIC_RELAXED, __HIP_MEMORY_SCOPE_AGENT); }
__device__ __forceinline__ unsigned xb_xcc_id() { return (unsigned)__builtin_amdgcn_s_getreg((3 << 11) | 20) & 0xFu; }
#define XB_SPIN(cond, bar) do { unsigned _sp = 0; while (cond) { __builtin_amdgcn_s_sleep(1); \
    if ((++_sp & 255u) == 0u) { if (xb_ld(&(bar)[XB_TMO])) break; if (_sp > XB_SPIN_CAP) { atomicAdd(&(bar)[XB_TMO], 1u); break; } } } } while (0)
struct XcdBarrier {
  unsigned* bar;
  unsigned x;
  volatile LAS unsigned* st;
};
__device__ __forceinline__ XcdBarrier xcd_barrier_post(unsigned* bar, volatile LAS unsigned* st) {
  XcdBarrier b;
  b.bar = bar;
  b.x = xb_xcc_id();
  b.st = st;
  if (threadIdx.x == 0) (void)xb_add(&bar[XB_XCNT(b.x)], 1u);
  return b;
}
__device__ __forceinline__ void xcd_barrier_complete(unsigned* bar, unsigned x, unsigned& nloc, unsigned& nx) {
  const unsigned G = gridDim.x * gridDim.y * gridDim.z;
  unsigned sum, cnt, mine, sp = 0u;
  for (;;) {
    sum = 0u; cnt = 0u; mine = 0u;
#pragma unroll
    for (unsigned j = 0; j < 16; ++j) {
      const unsigned c = xb_ld(&bar[XB_XCNT(j)]);
      sum += c;
      cnt += (c > 0u) ? 1u : 0u;
      mine = (j == x) ? c : mine;
    }
    if (sum == G) break;
    __builtin_amdgcn_s_sleep(1);
    if ((++sp & 255u) == 0u) {
      if (xb_ld(&bar[XB_TMO])) break;
      if (sp > XB_SPIN_CAP) { atomicAdd(&bar[XB_TMO], 1u); break; }
    }
  }
  nloc = mine > 0u ? mine : 1u;
  nx = cnt > 0u ? cnt : 1u;
}
__device__ __forceinline__ void xcd_barrier(const XcdBarrier& b) {
  asm volatile("s_waitcnt vmcnt(0)" ::: "memory");
  __syncthreads();
  if (threadIdx.x == 0) {
    unsigned* bar = b.bar;
    __builtin_amdgcn_s_waitcnt(0);
    unsigned nloc = b.st[0], nx = b.st[1];
    if (nloc == 0u) { xcd_barrier_complete(bar, b.x, nloc, nx); b.st[0] = nloc; b.st[1] = nx; }
    const unsigned old = xb_add(&bar[XB_XSUB(b.x)], 1u);
    const unsigned gen = old / nloc;
    if (old + 1u == (gen + 1u) * nloc) {
      __builtin_amdgcn_fence(__ATOMIC_RELEASE, "agent");
      asm volatile("s_waitcnt vmcnt(0)" ::: "memory");
      const unsigned og = xb_add(&bar[XB_TOP], 1u);
      const unsigned tg = og / nx;
      if (og + 1u == (tg + 1u) * nx) xb_add(&bar[XB_TOPGEN], 1u);
      else XB_SPIN(xb_ld(&bar[XB_TOPGEN]) == tg, bar);
      __builtin_amdgcn_fence(__ATOMIC_ACQUIRE, "agent");
      xb_add(&bar[XB_XGEN(b.x)], 1u);
      asm volatile("s_waitcnt vmcnt(0)" ::: "memory");
    } else {
      XB_SPIN(xb_ld(&bar[XB_XGEN(b.x)]) == gen, bar);
      __builtin_amdgcn_fence(__ATOMIC_ACQUIRE, "agent");
      asm volatile("s_waitcnt vmcnt(0)" ::: "memory");
    }
  }
  __syncthreads();
}


#define GLD 72
#define GEMM_LDS (2 * 128 * GLD * 2)
template <bool TRANS, int K>
__device__ __forceinline__ void gemm128(const bfraw* __restrict__ A, int lda, const bfraw* __restrict__ Bsw, int nt32_0,
                                        bfraw* sm, f32x16 (&acc)[4]) {
  const int tid = otid(), lane = tid & 63, wave = tid >> 6, r = lane & 31, h = lane >> 5;
  constexpr int KS = K >> 4;
  constexpr int nk = K >> 6;
  bfraw* sA = sm;
  const int lr = tid >> 3, lc = (tid & 7) * 8;
  const bfraw* ga = A + (size_t)lr * lda + lc;
  const bfraw* gb0 = Bsw + ((size_t)(nt32_0 + wave) * KS * 64 + lane) * 8;
  uint4 pa0, pa1, pa2, pa3, qa0, qa1, qa2, qa3;
  Frag bf[2][4];
#define GL(S)                                              \
  S##a0 = *(const uint4*)(ga);                             \
  S##a1 = *(const uint4*)(ga + (size_t)32 * lda);          \
  S##a2 = *(const uint4*)(ga + (size_t)64 * lda);          \
  S##a3 = *(const uint4*)(ga + (size_t)96 * lda);
#define SL(S, buf)                                                         \
  *(uint4*)(sA + (buf) * 128 * GLD + lr * GLD + lc) = S##a0;              \
  *(uint4*)(sA + (buf) * 128 * GLD + (lr + 32) * GLD + lc) = S##a1;       \
  *(uint4*)(sA + (buf) * 128 * GLD + (lr + 64) * GLD + lc) = S##a2;       \
  *(uint4*)(sA + (buf) * 128 * GLD + (lr + 96) * GLD + lc) = S##a3;
#define BL(set, kt_)                                                                       \
  _Pragma("unroll") for (int ks = 0; ks < 4; ++ks) {                                       \
    bf[set][ks].u = *(const uint4*)(gb0 + (size_t)((kt_) * 4 + ks) * 512);                 \
  }
#define COMPUTE(buf, set)                                                         \
  {                                                                               \
    const bfraw* cA = sA + (buf) * 128 * GLD + r * GLD + h * 8;                   \
    _Pragma("unroll") for (int ks = 0; ks < 4; ++ks) {                            \
      _Pragma("unroll") for (int mi = 0; mi < 4; ++mi) {                          \
        Frag a0;                                                                  \
        a0.u = *(const uint4*)(cA + mi * 32 * GLD + ks * 16);                     \
        if (TRANS) acc[mi] = mfma32(bf[set][ks], a0, acc[mi]);                    \
        else acc[mi] = mfma32(a0, bf[set][ks], acc[mi]);                          \
      }                                                                           \
    }                                                                             \
  }
  GL(p)
  BL(0, 0)
  ga += 64;
  GL(q)
#pragma unroll
  for (int i = 0; i < 4; ++i) acc[i] = zero16();
  SL(p, 0)
  __syncthreads();
#pragma unroll
  for (int kt = 0; kt < nk; kt += 2) {
    if (kt + 2 < nk) {
      ga += 64;
      GL(p)
    }
    BL(1, kt + 1)
    COMPUTE(0, 0)
    SL(q, 1)
    __syncthreads();
    if (kt + 3 < nk) {
      ga += 64;
      GL(q)
    }
    if (kt + 2 < nk) {
      BL(0, kt + 2)
    }
    COMPUTE(1, 1)
    if (kt + 2 < nk) {
      SL(p, 0)
    }
    __syncthreads();
  }
#undef GL
#undef SL
#undef BL
#undef COMPUTE
}


#define ELD 136
template <bool TRANS>
__device__ __forceinline__ void stage_tile(bfraw* sT, const f32x16 (&acc)[4]) {
  const int tid_ = otid(); const int lane = tid_ & 63, wave = tid_ >> 6, r = lane & 31, h = lane >> 5;
#pragma unroll
  for (int mi = 0; mi < 4; ++mi)
#pragma unroll
    for (int g = 0; g < 4; ++g) {
      const int lrow = TRANS ? (mi * 32 + r) : (wave * 32 + r);
      const int lcol = TRANS ? (wave * 32 + 8 * g + 4 * h) : (mi * 32 + 8 * g + 4 * h);
      *(uint2*)(sT + lrow * ELD + lcol) =
          make_uint2(pack2(acc[mi][4 * g + 0], acc[mi][4 * g + 1]), pack2(acc[mi][4 * g + 2], acc[mi][4 * g + 3]));
    }
}

__device__ __forceinline__ int xcd_remap(int t, int T) { return (T & 7) ? t : (t & 7) * (T >> 3) + (t >> 3); }

__device__ __forceinline__ void rowinfo(int row, int& b, int& kpos, int& l, bool& isctx) {
  if (row < NLAT) {
    b = row >> 11;
    l = row & 2047;
    kpos = CTX + l;
    isctx = false;
  } else {
    int r2 = row - NLAT;
    b = r2 >> 8;
    l = r2 & 255;
    kpos = l;
    isctx = true;
  }
}
__device__ __forceinline__ int keyrow(int b, int kpos) { return kpos < CTX ? NLAT + b * CTX + kpos : b * SEQ + (kpos - CTX); }

__device__ void conv_weight_tile(const float* __restrict__ src, int Ksz, int Nsz, bfraw* __restrict__ dst, int kt, int nt,
                                 const float* __restrict__ kscale, float* sT, bool kvperm = false) {
  const int tid = otid();
  __syncthreads();
#pragma unroll
  for (int i = 0; i < 4; ++i) {
    const int idx = tid + 256 * i;
    const int k = idx >> 4, n4 = (idx & 15) * 4;
    const int gk = kt * 64 + k, gn = nt * 64 + n4;
    float4 v = make_float4(0.f, 0.f, 0.f, 0.f);
    if (gn < Nsz) {
      v = *(const float4*)(src + (size_t)gk * Nsz + gn);
      if (kscale) {
        const float sc = kscale[gk];
        v.x *= sc; v.y *= sc; v.z *= sc; v.w *= sc;
      }
    }
    *(float4*)(sT + k * 68 + n4) = v;
  }
  __syncthreads();
#pragma unroll
  for (int i = 0; i < 2; ++i) {
    const int o = tid + 256 * i;
    const int n = o & 63, ko = o >> 6;
    const float* c = sT + (ko * 8) * 68 + n;
    uint4 w;
    w.x = pack2(c[0 * 68], c[1 * 68]);
    w.y = pack2(c[2 * 68], c[3 * 68]);
    w.z = pack2(c[4 * 68], c[5 * 68]);
    w.w = pack2(c[6 * 68], c[7 * 68]);
    int gn = nt * 64 + n;
    if (kvperm) gn = ((gn >> 6) & 1) * 512 + (gn >> 7) * 64 + (gn & 63);
    const int gk0 = kt * 64 + ko * 8;
    *(uint4*)(dst + ((((size_t)(gn >> 5) * (Ksz >> 4) + (gk0 >> 4)) * 64) + ((gk0 >> 3) & 1) * 32 + (gn & 31)) * 8) = w;
  }
}

__device__ void phase0a(const Params& p, unsigned char* smem, int part) {
  const int tid = otid();
  float* sf = (float*)smem;
  const int T_MOD = 192;
  const int T_IN = 16 * 44, T_OUT = 16 * 16, T_UQ = 4 * 12, T_UKV = 2 * 16, T_PW = 4 * 4;
  const int T_W = T_IN + T_OUT + T_UQ + T_UKV + T_PW;
  const bool split = gridDim.x > (unsigned)(T_MOD + 64);
  if (part == 1 && split) return;
  const int total = (part == 0 && !split) ? T_MOD : T_MOD + 2 * T_W + 1;
  int tstart, tstep;
  if (part == 0 && split) {
    if ((int)blockIdx.x < T_MOD) { tstart = blockIdx.x; tstep = 1 << 30; }
    else { tstart = T_MOD + ((int)blockIdx.x - T_MOD); tstep = (int)gridDim.x - T_MOD; }
  } else {
    tstart = blockIdx.x + (part == 0 ? 0 : T_MOD);
    tstep = gridDim.x;
  }
  for (int t = tstart; t < total && t >= 0; t = (tstep == (1 << 30)) ? total : t + tstep) {
    if (t < T_MOD) {
      const int l = t / 96, jt = t % 96;
      __syncthreads();
      for (int i = tid; i < 9 * 1024; i += 256) {
        int rr = i >> 10, k = i & 1023;
        float cv = rr < 8 ? p.c[rr * 1024 + k] : p.c_ctx[k];
        sf[i] = siluf(cv);
      }
      __syncthreads();
      const int col = tid & 31, kg = tid >> 5;
      float a[9];
#pragma unroll
      for (int rr = 0; rr < 9; ++rr) a[rr] = 0.f;
      const float* w = p.w_mod + (size_t)l * 1024 * 3072 + jt * 32 + col;
      for (int kb = kg * 128; kb < kg * 128 + 128; kb += 16) {
        float wv[16];
#pragma unroll
        for (int u = 0; u < 16; ++u) wv[u] = w[(size_t)(kb + u) * 3072];
#pragma unroll
        for (int u = 0; u < 16; ++u)
#pragma unroll
          for (int rr = 0; rr < 9; ++rr) a[rr] += sf[rr * 1024 + kb + u] * wv[u];
      }
      float* sR = sf + 9 * 1024;
#pragma unroll
      for (int rr = 0; rr < 9; ++rr) sR[(kg * 9 + rr) * 32 + col] = a[rr];
      __syncthreads();
      for (int i = tid; i < 288; i += 256) {
        int rr = i >> 5, cc = i & 31;
        float s = 0.f;
        for (int g = 0; g < 8; ++g) s += sR[(g * 9 + rr) * 32 + cc];
        s += p.b_mod[l * 3072 + jt * 32 + cc];
        p.mod[((size_t)l * 9 + rr) * 3072 + jt * 32 + cc] = s;
      }
    } else if (t < T_MOD + 2 * T_W) {
      int tt = t - T_MOD;
      const int l = tt / T_W;
      tt %= T_W;
      if (tt < T_IN) {
        conv_weight_tile(p.w_in + (size_t)l * 1024 * INC, 1024, INC, p.wt_in + (size_t)l * INCP * 1024, tt / 44, tt % 44, nullptr, sf);
      } else if ((tt -= T_IN) < T_OUT) {
        conv_weight_tile(p.w_out + (size_t)l * 1024 * 1024, 1024, 1024, p.wt_out + (size_t)l * 1024 * 1024, tt / 16, tt % 16, nullptr, sf);
      } else if ((tt -= T_OUT) < T_UQ) {
        conv_weight_tile(p.w_uq + (size_t)l * 256 * 768, 256, 768, p.wt_uq + (size_t)l * 768 * 256, tt / 12, tt % 12, p.g_q + l * 256, sf);
      } else if ((tt -= T_UQ) < T_UKV) {
        conv_weight_tile(p.w_ukv + (size_t)l * 128 * 1024, 128, 1024, p.wt_ukv + (size_t)l * 1024 * 128, tt / 16, tt % 16, p.g_kv + l * 128, sf, true);
      } else {
        tt -= T_UKV;
        conv_weight_tile(p.pw + (size_t)l * 256 * 256, 256, 256, p.wt_pw + (size_t)l * 256 * 256, tt / 4, tt % 4, nullptr, sf);
      }
    } else {
      for (int i = tid; i < 64 * 8; i += 256) {
        int pos = i >> 3, f = i & 7;
        float inv = powf(10000.0f, -(float)(2 * f) / 16.0f);
        float ang = (float)pos * inv;
        p.tabA[i] = make_float2(cosf(ang), sinf(ang));
      }
      for (int i = tid; i < 64 * 16; i += 256) {
        int pos = i >> 4, f = i & 15;
        float inv = powf(10000.0f, -(float)(2 * f) / 32.0f);
        float ang = (float)pos * inv;
        p.tabB[i] = make_float2(cosf(ang), sinf(ang));
      }
    }
  }
}

__device__ void phase_rows(const Params& p, int layer, bool is_prep) {
  const int tid_ = otid(); const int lane = tid_ & 63, wave = tid_ >> 6;
  const int gw = blockIdx.x * 4 + wave, nw = gridDim.x * 4;
  const bool last = (!is_prep) && (layer == 1);
  const int nrows = last ? NLAT : NROW;
  const bfraw* Y = p.P;
  float4 cx[4];
  uint2 cy[4];
#define ROW_XIN(rw) ((is_prep || layer == 0) ? ((rw) >= NLAT ? p.ctx + (size_t)((rw) - NLAT) * DM : p.x + (size_t)(rw) * DM) \
                                             : (const float*)p.out + (size_t)(rw) * DM)
  if (gw < nrows) {
    const float* xi = ROW_XIN(gw);
#pragma unroll
    for (int i = 0; i < 4; ++i) {
      cx[i] = *(const float4*)(xi + i * 256 + lane * 4);
      if (!is_prep) cy[i] = *(const uint2*)(Y + (size_t)gw * DM + i * 256 + lane * 4);
    }
  }
  for (int row = gw; row < nrows; row += nw) {
    int b, kpos, l;
    bool isctx;
    rowinfo(row, b, kpos, l, isctx);
    const int mrow = isctx ? 8 : b;
    float* xout = nullptr;
    if (!is_prep) xout = (layer == 0) ? (isctx ? p.HC1 + (size_t)(row - NLAT) * DM : p.out + (size_t)row * DM) : p.out + (size_t)row * DM;
    float4 nx[4];
    uint2 ny[4];
    const int nrow = row + nw;
    if (nrow < nrows) {
      const float* xi = ROW_XIN(nrow);
#pragma unroll
      for (int i = 0; i < 4; ++i) {
        nx[i] = *(const float4*)(xi + i * 256 + lane * 4);
        if (!is_prep) ny[i] = *(const uint2*)(Y + (size_t)nrow * DM + i * 256 + lane * 4);
      }
    }
    float v[16];
#pragma unroll
    for (int i = 0; i < 4; ++i) {
      v[i * 4 + 0] = cx[i].x;
      v[i * 4 + 1] = cx[i].y;
      v[i * 4 + 2] = cx[i].z;
      v[i * 4 + 3] = cx[i].w;
    }
    if (!is_prep) {
      const float* md = p.mod + ((size_t)layer * 9 + mrow) * 3072 + 2048;
      const float* lg = p.ln_g + layer * DM;
      const float* lb = p.ln_b + layer * DM;
      float s = 0.f;
#pragma unroll
      for (int i = 0; i < 4; ++i) {
        float4 g4 = *(const float4*)(md + i * 256 + lane * 4);
        const uint2 y2 = cy[i];
        v[i * 4 + 0] = ALPHA_F * v[i * 4 + 0] + g4.x * lo_bf(y2.x);
        v[i * 4 + 1] = ALPHA_F * v[i * 4 + 1] + g4.y * hi_bf(y2.x);
        v[i * 4 + 2] = ALPHA_F * v[i * 4 + 2] + g4.z * lo_bf(y2.y);
        v[i * 4 + 3] = ALPHA_F * v[i * 4 + 3] + g4.w * hi_bf(y2.y);
      }
#pragma unroll
      for (int i = 0; i < 16; ++i) s += v[i];
      float mu = wave_sum(s) * (1.0f / DM);
      float q = 0.f;
#pragma unroll
      for (int i = 0; i < 16; ++i) {
        float d = v[i] - mu;
        q += d * d;
      }
      float rstd = rsqrtf(wave_sum(q) * (1.0f / DM) + EPSF);
#pragma unroll
      for (int i = 0; i < 4; ++i) {
        float4 g4 = *(const float4*)(lg + i * 256 + lane * 4);
        float4 b4 = *(const float4*)(lb + i * 256 + lane * 4);
        v[i * 4 + 0] = (v[i * 4 + 0] - mu) * rstd * g4.x + b4.x;
        v[i * 4 + 1] = (v[i * 4 + 1] - mu) * rstd * g4.y + b4.y;
        v[i * 4 + 2] = (v[i * 4 + 2] - mu) * rstd * g4.z + b4.z;
        v[i * 4 + 3] = (v[i * 4 + 3] - mu) * rstd * g4.w + b4.w;
        *(float4*)(xout + i * 256 + lane * 4) = make_float4(v[i * 4 + 0], v[i * 4 + 1], v[i * 4 + 2], v[i * 4 + 3]);
      }
    }
    if (!last) {
      const int nl = is_prep ? 0 : layer + 1;
      const float* md = p.mod + ((size_t)nl * 9 + mrow) * 3072;
      float s = 0.f;
#pragma unroll
      for (int i = 0; i < 16; ++i) s += v[i];
      float mu = wave_sum(s) * (1.0f / DM);
      float q = 0.f;
#pragma unroll
      for (int i = 0; i < 16; ++i) {
        float d = v[i] - mu;
        q += d * d;
      }
      float rstd = rsqrtf(wave_sum(q) * (1.0f / DM) + EPSF);
#pragma unroll
      for (int i = 0; i < 4; ++i) {
        float4 sh = *(const float4*)(md + i * 256 + lane * 4);
        float4 sc = *(const float4*)(md + 1024 + i * 256 + lane * 4);
        float u0 = (v[i * 4 + 0] - mu) * rstd * (1.f + sc.x) + sh.x;
        float u1 = (v[i * 4 + 1] - mu) * rstd * (1.f + sc.y) + sh.y;
        float u2 = (v[i * 4 + 2] - mu) * rstd * (1.f + sc.z) + sh.z;
        float u3 = (v[i * 4 + 3] - mu) * rstd * (1.f + sc.w) + sh.w;
        *(uint2*)(p.U + (size_t)row * DM + i * 256 + lane * 4) = make_uint2(pack2(u0, u1), pack2(u2, u3));
      }
    }
#pragma unroll
    for (int i = 0; i < 4; ++i) {
      cx[i] = nx[i];
      cy[i] = ny[i];
    }
  }
#undef ROW_XIN
}

__device__ __forceinline__ void rope16_acc(const Params& p, f32x16& a, int l, int h) {
#pragma unroll
  for (int part = 0; part < 2; ++part) {
    const int pos = part ? (l & 63) : (l >> 6);
#pragma unroll
    for (int q = 0; q < 4; ++q) {
      const int reg = part * 8 + q;
      const float2 cs = p.tabA[pos * 8 + q + 4 * h];
      const float x1 = a[reg], x2 = a[reg + 4];
      a[reg] = x1 * cs.x - x2 * cs.y;
      a[reg + 4] = x1 * cs.y + x2 * cs.x;
    }
  }
}

__device__ void phase1(const Params& p, int layer, unsigned char* smem) {
  const int tid = otid(), lane = tid & 63, wave = tid >> 6, r = lane & 31, h = lane >> 5;
  const int wm = wave >> 1, wn = wave & 1;
  const int NT = 22, MT = NROW / 128;
  const bfraw* W = p.wt_in + (size_t)layer * INCP * 1024;
  bfraw* sT = (bfraw*)smem;
  const int n_lat = (NLAT / 128) * NT;
  const int total = layer == 0 ? MT * NT : n_lat + (NCTX / 128) * 7;
  for (int t0_ = blockIdx.x; t0_ < total; t0_ += gridDim.x) {
    const int t = xcd_remap(t0_, total);
    int mt, nt;
    if (t < n_lat || layer == 0) {
      mt = t / NT;
      nt = t % NT;
    } else {
      const int tt = t - n_lat, j = tt % 7;
      mt = NLAT / 128 + tt / 7;
      nt = j < 2 ? 2 + j : 7 + j;
    }
    const int m0 = mt * 128, n0 = nt * 128;
    f32x16 acc[4];
    gemm128<true, 1024>(p.U + (size_t)m0 * DM, DM, W, n0 >> 5, (bfraw*)smem, acc);
    const bool lat = m0 < NLAT;
    const int cg0 = n0 + wave * 32;
    if (lat) {
      if (cg0 >= C_RQ && cg0 < C_RV) {
        const float ksc = cg0 >= C_RK ? 0.125f : 1.0f;
        const int second = ((cg0 - C_RQ) >> 5) & 1;
#pragma unroll
        for (int mi = 0; mi < 4; ++mi) {
          const int l = (m0 + mi * 32 + r) & 2047;
          const int pos = second ? (l & 63) : (l >> 6);
#pragma unroll
          for (int reg = 0; reg < 8; ++reg) {
            const int fi = (reg & 3) + 8 * (reg >> 2) + 4 * h;
            const float2 cs = p.tabB[pos * 16 + fi];
            const float x1 = acc[mi][reg], x2 = acc[mi][reg + 8];
            acc[mi][reg] = (x1 * cs.x - x2 * cs.y) * ksc;
            acc[mi][reg + 8] = (x1 * cs.y + x2 * cs.x) * ksc;
          }
        }
      } else if (cg0 == C_PKR) {
#pragma unroll
        for (int mi = 0; mi < 4; ++mi) rope16_acc(p, acc[mi], (m0 + mi * 32 + r) & 2047, h);
      }
    } else if (cg0 >= C_RK && cg0 < C_RV) {
#pragma unroll
      for (int mi = 0; mi < 4; ++mi)
#pragma unroll
        for (int reg = 0; reg < 16; ++reg) acc[mi][reg] *= 0.125f;
    }
    stage_tile<true>(sT, acc);
    __syncthreads();
#pragma unroll 2
    for (int i = 0; i < 8; ++i) {
      const int chunk = tid + 256 * i;
      const int row = chunk >> 4, cc = (chunk & 15) * 8;
      if (n0 + cc < INC) *(uint4*)(p.P + (size_t)(m0 + row) * INC + n0 + cc) = *(const uint4*)(sT + row * ELD + cc);
    }
    __syncthreads();
  }
}

template <int NCOL>
__device__ __forceinline__ void row_rstd(const bfraw* __restrict__ src, int ld, float* sR) {
  const int tid = otid();
  const int row = tid >> 1, half = tid & 1;
  constexpr int PER = NCOL >> 1, NL = PER >> 3;
  const bfraw* s = src + (size_t)row * ld + half * PER;
  uint4 u[NL];
#pragma unroll
  for (int i = 0; i < NL; ++i) u[i] = *(const uint4*)(s + i * 8);
  float q0 = 0.f, q1 = 0.f, q2 = 0.f, q3 = 0.f;
#pragma unroll
  for (int i = 0; i < NL; ++i) {
    float a;
    a = lo_bf(u[i].x); q0 += a * a; a = hi_bf(u[i].x); q1 += a * a;
    a = lo_bf(u[i].y); q2 += a * a; a = hi_bf(u[i].y); q3 += a * a;
    a = lo_bf(u[i].z); q0 += a * a; a = hi_bf(u[i].z); q1 += a * a;
    a = lo_bf(u[i].w); q2 += a * a; a = hi_bf(u[i].w); q3 += a * a;
  }
  float q = (q0 + q1) + (q2 + q3);
  q += __shfl_xor(q, 1);
  if (half == 0) sR[row] = rsqrtf(q / (float)NCOL + EPSF);
}

__device__ void task_qup(const Params& p, int layer, int mt, int nt, unsigned char* smem) {
  const int tid = otid(), lane = tid & 63, wave = tid >> 6, r = lane & 31, h = lane >> 5;
  const int wm = wave >> 1, wn = wave & 1;
  const int m0 = mt * 128, n0 = nt * 128;
  float* sR = (float*)(smem + GEMM_LDS);
  bfraw* sT = (bfraw*)smem;
  __syncthreads();
  row_rstd<256>(p.P + (size_t)m0 * INC + C_PQ, INC, sR);
  f32x16 acc[4];
  gemm128<true, 256>(p.P + (size_t)m0 * INC + C_PQ, INC, p.wt_uq + (size_t)layer * 768 * 256, n0 >> 5, (bfraw*)smem, acc);
  const bool lat = m0 < NLAT;
  const float qs = 0.10206207261596577f * 1.4426950408889634f;
  const int ctile = (n0 + wave * 32) >> 5;
#pragma unroll
  for (int mi = 0; mi < 4; ++mi) {
    const int rl = mi * 32 + r;
    const float sc = sR[rl] * qs;
#pragma unroll
    for (int reg = 0; reg < 16; ++reg) acc[mi][reg] *= sc;
    if (lat && (ctile % 3) == 2) rope16_acc(p, acc[mi], (m0 + rl) & 2047, h);
  }
  stage_tile<true>(sT, acc);
  __syncthreads();
  int b, kpos0, l0;
  bool isctx;
  rowinfo(m0, b, kpos0, l0, isctx);
#pragma unroll 2
  for (int i = 0; i < 8; ++i) {
    const int chunk = tid + 256 * i;
    const int row = chunk >> 4, cc = (chunk & 15) * 8;
    const int c = n0 + cc;
    const int head = c / 96, d = c % 96;
    *(uint4*)(p.Q + (((size_t)b * 8 + head) * LKEYS + kpos0 + row) * 96 + d) = *(const uint4*)(sT + row * ELD + cc);
  }
}

__device__ void task_kvup(const Params& p, int layer, int mt, int nt, unsigned char* smem) {
  const int tid = otid(), lane = tid & 63, wave = tid >> 6, r = lane & 31, h = lane >> 5;
  const int wm = wave >> 1;
  const int m0 = mt * 128, n0 = nt * 128;
  float* sR = (float*)(smem + GEMM_LDS);
  bfraw* sT = (bfraw*)smem;
  __syncthreads();
  row_rstd<128>(p.P + (size_t)m0 * INC + C_PKV, INC, sR);
  f32x16 acc[4];
  int b, kpos0, l0;
  bool isctx;
  rowinfo(m0, b, kpos0, l0, isctx);
  const bfraw* A = p.P + (size_t)m0 * INC + C_PKV;
  const bfraw* W = p.wt_ukv + (size_t)layer * 1024 * 128;
  if (nt == 0) {
#pragma unroll
    for (int i = 0; i < 2; ++i) {
      const int chunk = tid + 256 * i;
      const int row = chunk >> 2, cc = (chunk & 3) * 8;
      *(uint4*)(p.KR + ((size_t)b * LKEYS + kpos0 + row) * 32 + cc) = *(const uint4*)(p.P + (size_t)(m0 + row) * INC + C_PKR + cc);
    }
  }
  if (nt < 4) {
    gemm128<true, 128>(A, INC, W, n0 >> 5, (bfraw*)smem, acc);
#pragma unroll
    for (int mi = 0; mi < 4; ++mi) {
      const float sc = sR[mi * 32 + r];
#pragma unroll
      for (int reg = 0; reg < 16; ++reg) acc[mi][reg] *= sc;
    }
    stage_tile<true>(sT, acc);
    __syncthreads();
#pragma unroll 2
    for (int i = 0; i < 8; ++i) {
      const int chunk = tid + 256 * i;
      const int row = chunk >> 4, cc = (chunk & 15) * 8;
      const int head = nt * 2 + (cc >> 6), d = cc & 63;
      *(uint4*)(p.KN + (((size_t)b * 8 + head) * LKEYS + kpos0 + row) * 64 + d) = *(const uint4*)(sT + row * ELD + cc);
    }
  } else {
    gemm128<false, 128>(A, INC, W, n0 >> 5, (bfraw*)smem, acc);
#pragma unroll
    for (int mi = 0; mi < 4; ++mi)
#pragma unroll
      for (int reg = 0; reg < 16; ++reg) acc[mi][reg] *= sR[mi * 32 + (reg & 3) + 8 * (reg >> 2) + 4 * h];
    stage_tile<false>(sT, acc);
    __syncthreads();
#pragma unroll 2
    for (int i = 0; i < 8; ++i) {
      const int chunk = tid + 256 * i;
      const int crow = chunk >> 4, cc = (chunk & 15) * 8;
      const int head = (nt - 4) * 2 + (crow >> 6), d = crow & 63;
      *(uint4*)(p.VT + (((size_t)b * 8 + head) * 64 + d) * LKEYS + kpos0 + cc) = *(const uint4*)(sT + crow * ELD + cc);
    }
  }
}

__device__ __forceinline__ int chunk_row0(int b, int c) { return c < 2 ? NLAT + b * CTX + c * 128 : b * SEQ + (c - 2) * 128; }
__device__ __forceinline__ float log2_sigmoid(float x) { return -log1pf(expf(-x)) * 1.4426950408889634f; }

#define TLD 136
__device__ void task_chunkstate(const Params& p, int layer, int b, int hd, int c, unsigned char* smem) {
  const int tid = otid(), lane = tid & 63, wave = tid >> 6, r = lane & 31, h = lane >> 5;
  bfraw* sKf = (bfraw*)smem;
  bfraw* sKb = sKf + 64 * TLD;
  bfraw* sV = sKb + 64 * TLD;
  const int R0 = chunk_row0(b, c);
  const float lgf = log2_sigmoid(p.dec_f[layer * 4 + hd]);
  const float lgb = log2_sigmoid(p.dec_b[layer * 4 + hd]);
  __syncthreads();
  {
    const int tok = tid >> 1, d0 = (tid & 1) * 32;
    const bfraw* kp = p.P + (size_t)(R0 + tok) * INC + C_RK + hd * 64 + d0;
    const bfraw* vp = p.P + (size_t)(R0 + tok) * INC + C_RV + hd * 64 + d0;
    const float wf = exp2f(lgf * (float)(127 - tok));
    const float wb = exp2f(lgb * (float)tok);
#pragma unroll
    for (int i = 0; i < 4; ++i) {
      uint4 ku = *(const uint4*)(kp + i * 8);
      uint4 vu = *(const uint4*)(vp + i * 8);
      unsigned kw[4] = {ku.x, ku.y, ku.z, ku.w};
      unsigned vw[4] = {vu.x, vu.y, vu.z, vu.w};
#pragma unroll
      for (int j = 0; j < 4; ++j) {
        const int d = d0 + i * 8 + j * 2;
        float k0 = lo_bf(kw[j]), k1 = hi_bf(kw[j]);
        sKf[d * TLD + tok] = f2bf(k0 * wf);
        sKf[(d + 1) * TLD + tok] = f2bf(k1 * wf);
        sKb[d * TLD + tok] = f2bf(k0 * wb);
        sKb[(d + 1) * TLD + tok] = f2bf(k1 * wb);
        sV[d * TLD + tok] = (bfraw)(vw[j] & 0xffffu);
        sV[(d + 1) * TLD + tok] = (bfraw)(vw[j] >> 16);
      }
    }
  }
  __syncthreads();
  const int dir = wave >> 1, mi = wave & 1;
  const bfraw* sK = dir ? sKb : sKf;
  f32x16 acc0 = zero16(), acc1 = zero16();
#pragma unroll
  for (int ks = 0; ks < 8; ++ks) {
    Frag a, b0, b1;
    a.u = *(const uint4*)(sK + (mi * 32 + r) * TLD + ks * 16 + h * 8);
    b0.u = *(const uint4*)(sV + (r)*TLD + ks * 16 + h * 8);
    b1.u = *(const uint4*)(sV + (32 + r) * TLD + ks * 16 + h * 8);
    acc0 = mfma32(a, b0, acc0);
    acc1 = mfma32(a, b1, acc1);
  }
  float* dst = p.CST + ((((size_t)b * 4 + hd) * NCHUNK + c) * 2 + dir) * 4096;
#pragma unroll
  for (int reg = 0; reg < 16; ++reg) {
    const int dk = mi * 32 + (reg & 3) + 8 * (reg >> 2) + 4 * h;
    dst[dk * 64 + r] = acc0[reg];
    dst[dk * 64 + 32 + r] = acc1[reg];
  }
}

#define CT 32
#define ALD 264
__device__ void task_conv(const Params& p, int layer, int seqrow0, int L, int t0, unsigned char* smem) {
  const int tid = otid(), lane = tid & 63, wave = tid >> 6, r = lane & 31, h = lane >> 5;
  bfraw* sU = (bfraw*)smem;
  float* sC = (float*)(smem + 31744);
  bfraw* sA = (bfraw*)smem;
  __syncthreads();
  for (int i = tid; i < 62 * 32; i += 256) {
    const int rr = i >> 5, cc = (i & 31) * 8;
    const int tok = t0 - 15 + rr;
    uint4 o = make_uint4(0, 0, 0, 0);
    if (tok >= 0 && tok < L) {
      const bfraw* src = p.P + (size_t)(seqrow0 + tok) * INC + C_GLU + cc;
      uint4 a = *(const uint4*)(src);
      uint4 g = *(const uint4*)(src + 256);
      o.x = pack2(lo_bf(a.x) * sigmf(lo_bf(g.x)), hi_bf(a.x) * sigmf(hi_bf(g.x)));
      o.y = pack2(lo_bf(a.y) * sigmf(lo_bf(g.y)), hi_bf(a.y) * sigmf(hi_bf(g.y)));
      o.z = pack2(lo_bf(a.z) * sigmf(lo_bf(g.z)), hi_bf(a.z) * sigmf(hi_bf(g.z)));
      o.w = pack2(lo_bf(a.w) * sigmf(lo_bf(g.w)), hi_bf(a.w) * sigmf(hi_bf(g.w)));
    }
    *(uint4*)(sU + rr * 256 + cc) = o;
  }
  __syncthreads();
  {
    const int ch = tid;
    float w[31];
#pragma unroll
    for (int j = 0; j < 31; ++j) w[j] = p.dw[((size_t)layer * 31 + j) * 256 + ch];
    const float bias = p.dw_b[layer * 256 + ch];
    for (int t = 0; t < CT; ++t) {
      float a = bias;
#pragma unroll
      for (int j = 0; j < 31; ++j) a += w[j] * bf2f(sU[(t + j) * 256 + ch]);
      sC[t * 256 + ch] = a;
    }
  }
  __syncthreads();
  {
    const float4 g4 = *(const float4*)(p.cln_g + layer * 256 + lane * 4);
    const float4 b4 = *(const float4*)(p.cln_b + layer * 256 + lane * 4);
#pragma unroll
    for (int i = 0; i < 8; ++i) {
      const int t = wave * 8 + i;
      float4 v = *(const float4*)(sC + t * 256 + lane * 4);
      float mu = wave_sum(v.x + v.y + v.z + v.w) * (1.f / 256.f);
      float dx = v.x - mu, dy = v.y - mu, dz = v.z - mu, dw_ = v.w - mu;
      float rstd = rsqrtf(wave_sum(dx * dx + dy * dy + dz * dz + dw_ * dw_) * (1.f / 256.f) + EPSF);
      float y0 = siluf(dx * rstd * g4.x + b4.x), y1 = siluf(dy * rstd * g4.y + b4.y);
      float y2 = siluf(dz * rstd * g4.z + b4.z), y3 = siluf(dw_ * rstd * g4.w + b4.w);
      *(uint2*)(sA + t * ALD + lane * 4) = make_uint2(pack2(y0, y1), pack2(y2, y3));
    }
  }
  __syncthreads();
  {
    const bfraw* W = p.wt_pw + (size_t)layer * 256 * 256;
    f32x16 acc0 = zero16(), acc1 = zero16();
#pragma unroll 4
    for (int ks = 0; ks < 16; ++ks) {
      Frag a, b0, b1;
      a.u = *(const uint4*)(sA + r * ALD + ks * 16 + h * 8);
      b0.u = *(const uint4*)(W + ((size_t)((wave * 2 + 0) * 16 + ks) * 64 + lane) * 8);
      b1.u = *(const uint4*)(W + ((size_t)((wave * 2 + 1) * 16 + ks) * 64 + lane) * 8);
      acc0 = mfma32(b0, a, acc0);
      acc1 = mfma32(b1, a, acc1);
    }
    const size_t row = (size_t)seqrow0 + t0 + r;
    const bfraw* gp = p.P + row * INC + C_GCONV + wave * 64;
    bfraw* op = p.U + row * DM + 768 + wave * 64;
    const float* pbp = p.pw_b + layer * 256 + wave * 64;
#pragma unroll
    for (int g = 0; g < 4; ++g) {
      const int n = 8 * g + 4 * h;
      uint2 gu = *(const uint2*)(gp + n);
      float4 b4 = *(const float4*)(pbp + n);
      float x0 = (acc0[g * 4 + 0] + b4.x) * siluf(lo_bf(gu.x));
      float x1 = (acc0[g * 4 + 1] + b4.y) * siluf(hi_bf(gu.x));
      float x2 = (acc0[g * 4 + 2] + b4.z) * siluf(lo_bf(gu.y));
      float x3 = (acc0[g * 4 + 3] + b4.w) * siluf(hi_bf(gu.y));
      *(uint2*)(op + n) = make_uint2(pack2(x0, x1), pack2(x2, x3));
      gu = *(const uint2*)(gp + 32 + n);
      b4 = *(const float4*)(pbp + 32 + n);
      x0 = (acc1[g * 4 + 0] + b4.x) * siluf(lo_bf(gu.x));
      x1 = (acc1[g * 4 + 1] + b4.y) * siluf(hi_bf(gu.x));
      x2 = (acc1[g * 4 + 2] + b4.z) * siluf(lo_bf(gu.y));
      x3 = (acc1[g * 4 + 3] + b4.w) * siluf(hi_bf(gu.y));
      *(uint2*)(op + 32 + n) = make_uint2(pack2(x0, x1), pack2(x2, x3));
    }
  }
}

#ifdef ONLYT
#define ENT(n) ((n) == ONLYT)
#else
#define ENT(n) true
#endif
__device__ void phase2(const Params& p, int layer, unsigned char* smem) {
  const bool need_ctx = (layer == 0);
  const int n_q = (need_ctx ? NROW / 128 : NLAT / 128) * 6;
  const int n_kv = (NROW / 128) * 8;
  const int n_cs = NB * 4 * NCHUNK;
  const int n_cv = NB * 64 + (need_ctx ? NB * 8 : 0);
  const int total = n_q + n_kv + n_cs + n_cv;
  for (int t = blockIdx.x; t < total; t += gridDim.x) {
    int tt = t;
    if (tt < n_cv) {
      int seqrow0, L, t0;
      if (tt < NB * 64) {
        tt = xcd_remap(tt, NB * 64);
        seqrow0 = (tt >> 6) * SEQ; L = SEQ; t0 = (tt & 63) * CT;
      } else {
        tt -= NB * 64;
        seqrow0 = NLAT + (tt >> 3) * CTX; L = CTX; t0 = (tt & 7) * CT;
      }
      if (ENT(3)) task_conv(p, layer, seqrow0, L, t0, smem);
    } else if ((tt -= n_cv) < n_kv) {
      tt = xcd_remap(tt, n_kv);
      if (ENT(0)) task_kvup(p, layer, tt / 8, tt % 8, smem);
    } else if ((tt -= n_kv) < n_q) {
      tt = xcd_remap(tt, n_q);
      if (ENT(1)) task_qup(p, layer, tt / 6, tt % 6, smem);
    } else {
      tt -= n_q;
      const int c = tt % NCHUNK;
      const int bh = tt / NCHUNK;
      if (ENT(2)) task_chunkstate(p, layer, bh >> 2, bh & 3, c, smem);
    }
  }
}

#define KLD 104
#define VLD 72
__device__ __forceinline__ float fexp2(float x) { return __builtin_amdgcn_exp2f(x); }
__device__ __forceinline__ float xhalf_max(float x) {
  auto t = __builtin_amdgcn_permlane32_swap(__float_as_uint(x), __float_as_uint(x), false, false);
  return fmaxf(__uint_as_float(t[0]), __uint_as_float(t[1]));
}
__device__ __forceinline__ float xhalf_sum(float x) {
  auto t = __builtin_amdgcn_permlane32_swap(__float_as_uint(x), __float_as_uint(x), false, false);
  return __uint_as_float(t[0]) + __uint_as_float(t[1]);
}

__device__ void task_attn(const Params& p, int b, int hd, int qpos0, int nkeys, unsigned char* smem) {
  const int tid = otid(), lane = tid & 63, wave = tid >> 6, r = lane & 31, h = lane >> 5;
  bfraw* sK = (bfraw*)smem;
  bfraw* sV = sK + 2 * 64 * KLD;
  const size_t bh = (size_t)b * 8 + hd;
  const bfraw* KNp = p.KN + bh * LKEYS * 64;
  const bfraw* VTp = p.VT + bh * 64 * LKEYS;
  const int qpos = qpos0 + wave * 32 + r;
  Frag qf0, qf1, qf2, qf3, qf4, qf5;
  {
    const bfraw* qp = p.Q + (bh * LKEYS + qpos) * 96 + h * 8;
    qf0.u = *(const uint4*)(qp);
    qf1.u = *(const uint4*)(qp + 16);
    qf2.u = *(const uint4*)(qp + 32);
    qf3.u = *(const uint4*)(qp + 48);
    qf4.u = *(const uint4*)(qp + 64);
    qf5.u = *(const uint4*)(qp + 80);
  }
  const int k0key = tid / 12, k0cc = tid % 12;
  const int k1key = (tid + 256) / 12, k1cc = (tid + 256) % 12;
  const int k2key = (tid + 512) / 12, k2cc = (tid + 512) % 12;
  const int vd = tid >> 3, vcc = tid & 7;
  uint4 pk0, pk1, pk2, pv0, pv1;
#define KSRC(key, cc, key0)                                                                     \
  ((cc) < 8 ? (KNp + (size_t)((key0) + (key)) * 64 + (cc) * 8)                                   \
            : (p.KR + ((size_t)b * LKEYS + (key0) + (key)) * 32 + ((cc) - 8) * 8))
#define GLOAD(S, key0)                                                    \
  do {                                                                    \
    S##k0 = *(const uint4*)KSRC(k0key, k0cc, key0);                       \
    S##k1 = *(const uint4*)KSRC(k1key, k1cc, key0);                       \
    S##k2 = *(const uint4*)KSRC(k2key, k2cc, key0);                       \
    S##v0 = *(const uint4*)(VTp + (size_t)vd * LKEYS + (key0) + vcc * 8);        \
    S##v1 = *(const uint4*)(VTp + (size_t)(vd + 32) * LKEYS + (key0) + vcc * 8); \
  } while (0)
#define SSTORE(S, buf)                                                       \
  do {                                                                       \
    *(uint4*)(sK + (buf) * 64 * KLD + k0key * KLD + k0cc * 8) = S##k0;       \
    *(uint4*)(sK + (buf) * 64 * KLD + k1key * KLD + k1cc * 8) = S##k1;       \
    *(uint4*)(sK + (buf) * 64 * KLD + k2key * KLD + k2cc * 8) = S##k2;       \
    *(uint4*)(sV + (buf) * 64 * VLD + vd * VLD + vcc * 8) = S##v0;           \
    *(uint4*)(sV + (buf) * 64 * VLD + (vd + 32) * VLD + vcc * 8) = S##v1;    \
  } while (0)
#define ATT_TILE(buf)                                                              \
  {                                                                                \
    const bfraw* cK = sK + (buf) * 64 * KLD + r * KLD + h * 8;                     \
    const bfraw* cV = sV + (buf) * 64 * VLD + r * VLD + h * 4;                     \
    Frag ka[6], kb[6], va[4], vb[4];                                               \
    _Pragma("unroll") for (int ks = 0; ks < 6; ++ks) {                             \
      ka[ks].u = *(const uint4*)(cK + ks * 16);                                    \
      kb[ks].u = *(const uint4*)(cK + 32 * KLD + ks * 16);                         \
    }                                                                              \
    __builtin_amdgcn_sched_barrier(0);                                             \
    f32x16 s0 = zero16(), s1 = zero16();                                           \
    s0 = mfma32(ka[0], qf0, s0); s1 = mfma32(kb[0], qf0, s1);                      \
    s0 = mfma32(ka[1], qf1, s0); s1 = mfma32(kb[1], qf1, s1);                      \
    s0 = mfma32(ka[2], qf2, s0); s1 = mfma32(kb[2], qf2, s1);                      \
    s0 = mfma32(ka[3], qf3, s0); s1 = mfma32(kb[3], qf3, s1);                      \
    s0 = mfma32(ka[4], qf4, s0); s1 = mfma32(kb[4], qf4, s1);                      \
    s0 = mfma32(ka[5], qf5, s0); s1 = mfma32(kb[5], qf5, s1);                      \
    float mx = fmaxf(s0[0], s1[0]);                                                \
    _Pragma("unroll") for (int i = 1; i < 16; ++i) mx = fmaxf(mx, fmaxf(s0[i], s1[i])); \
    mx = xhalf_max(mx);                                            \
    if (__builtin_amdgcn_ballot_w64(mx > m + 8.0f) != 0ull) {                      \
        \
      const float mn = fmaxf(m, mx);                                               \
      const float al = fexp2(m - mn);                                              \
      m = mn;                                                                      \
      lsum *= al;                                                                  \
      _Pragma("unroll") for (int i = 0; i < 16; ++i) {                             \
        o0[i] *= al;                                                               \
        o1[i] *= al;                                                               \
      }                                                                            \
    }                                                                              \
    float ps;                                                                      \
    {                                                                              \
      const f2v mm = {m, m};                                                       \
      f2v ps2 = {0.f, 0.f};                                                        \
      _Pragma("unroll") for (int i = 0; i < 16; i += 2) {                          \
        f2v d0 = {s0[i], s0[i + 1]};                                               \
        f2v d1 = {s1[i], s1[i + 1]};                                               \
        d0 -= mm;                                                                  \
        d1 -= mm;                                                                  \
        d0.x = fexp2(d0.x); d0.y = fexp2(d0.y);                                    \
        d1.x = fexp2(d1.x); d1.y = fexp2(d1.y);                                    \
        ps2 += d0;                                                                 \
        ps2 += d1;                                                                 \
        s0[i] = d0.x; s0[i + 1] = d0.y;                                            \
        s1[i] = d1.x; s1[i + 1] = d1.y;                                            \
      }                                                                            \
      ps = ps2.x + ps2.y;                                                          \
    }                                                                              \
    _Pragma("unroll") for (int s = 0; s < 4; ++s) {                                \
      va[s].d[0] = *(const uint2*)(cV + s * 16);                                   \
      va[s].d[1] = *(const uint2*)(cV + s * 16 + 8);                               \
      vb[s].d[0] = *(const uint2*)(cV + 32 * VLD + s * 16);                        \
      vb[s].d[1] = *(const uint2*)(cV + 32 * VLD + s * 16 + 8);                    \
    }                                                                              \
    lsum += ps;                                                                    \
    _Pragma("unroll") for (int s = 0; s < 2; ++s) {                                \
      Frag pb;                                                                     \
      pb.w[0] = pack2(s0[8 * s + 0], s0[8 * s + 1]);                               \
      pb.w[1] = pack2(s0[8 * s + 2], s0[8 * s + 3]);                               \
      pb.w[2] = pack2(s0[8 * s + 4], s0[8 * s + 5]);                               \
      pb.w[3] = pack2(s0[8 * s + 6], s0[8 * s + 7]);                               \
      o0 = mfma32(va[s], pb, o0);                                                  \
      o1 = mfma32(vb[s], pb, o1);                                                  \
    }                                                                              \
    _Pragma("unroll") for (int s = 0; s < 2; ++s) {                                \
      Frag pb;                                                                     \
      pb.w[0] = pack2(s1[8 * s + 0], s1[8 * s + 1]);                               \
      pb.w[1] = pack2(s1[8 * s + 2], s1[8 * s + 3]);                               \
      pb.w[2] = pack2(s1[8 * s + 4], s1[8 * s + 5]);                               \
      pb.w[3] = pack2(s1[8 * s + 6], s1[8 * s + 7]);                               \
      o0 = mfma32(va[2 + s], pb, o0);                                              \
      o1 = mfma32(vb[2 + s], pb, o1);                                              \
    }                                                                              \
  }
#define QK(ks, qf)
  f32x16 o0 = zero16(), o1 = zero16();
  float m = -1e30f, lsum = 0.f;
  const int nt = nkeys >> 6;
  __syncthreads();
  GLOAD(p, 0);
  SSTORE(p, 0);
  __syncthreads();
  for (int kt = 0; kt < nt; kt += 2) {
    GLOAD(p, (kt + 1) * 64);
    ATT_TILE(0)
    SSTORE(p, 1);
    __syncthreads();
    if (kt + 2 < nt) GLOAD(p, (kt + 2) * 64);
    ATT_TILE(1)
    if (kt + 2 < nt) SSTORE(p, 0);
    __syncthreads();
  }
#undef QK
#undef ATT_TILE
#undef GLOAD
#undef SSTORE
#undef KSRC
  lsum = xhalf_sum(lsum);
  const float inv = 1.0f / lsum;
  const int row = keyrow(b, qpos);
  const bfraw* gp = p.P + (size_t)row * INC + C_GMLA + hd * 64;
  bfraw* op = p.U + (size_t)row * DM + hd * 64;
#pragma unroll
  for (int g = 0; g < 4; ++g) {
    const int d = 8 * g + 4 * h;
    uint2 gu = *(const uint2*)(gp + d);
    float x0 = o0[g * 4 + 0] * inv * siluf(lo_bf(gu.x));
    float x1 = o0[g * 4 + 1] * inv * siluf(hi_bf(gu.x));
    float x2 = o0[g * 4 + 2] * inv * siluf(lo_bf(gu.y));
    float x3 = o0[g * 4 + 3] * inv * siluf(hi_bf(gu.y));
    *(uint2*)(op + d) = make_uint2(pack2(x0, x1), pack2(x2, x3));
    gu = *(const uint2*)(gp + 32 + d);
    x0 = o1[g * 4 + 0] * inv * siluf(lo_bf(gu.x));
    x1 = o1[g * 4 + 1] * inv * siluf(hi_bf(gu.x));
    x2 = o1[g * 4 + 2] * inv * siluf(lo_bf(gu.y));
    x3 = o1[g * 4 + 3] * inv * siluf(hi_bf(gu.y));
    *(uint2*)(op + 32 + d) = make_uint2(pack2(x0, x1), pack2(x2, x3));
  }
}

__device__ void task_prefix(const Params& p, int layer, int pt) {
  const int tid = otid();
  const int bh = pt >> 4, dir = (pt >> 3) & 1, slice = pt & 7;
  const int hd = bh & 3;
  const float lg = log2_sigmoid(dir ? p.dec_b[layer * 4 + hd] : p.dec_f[layer * 4 + hd]);
  const float cd = exp2f(lg * 128.f);
  const size_t eoff = ((size_t)bh * NCHUNK) * 2 * 4096 + (size_t)dir * 4096 + slice * 512 + 2 * tid;
  const float* base = p.CST + eoff;
  bfraw* obase = p.PRE + eoff;
  float2 v[1][NCHUNK];
#pragma unroll
  for (int s2 = 0; s2 < NCHUNK; ++s2) {
    const int c2 = dir ? (s2 < 2 ? 1 - s2 : 19 - s2) : s2;
#pragma unroll
    for (int j = 0; j < 1; ++j) v[j][s2] = *(const float2*)(base + (size_t)c2 * 2 * 4096 + j * 512);
  }
  float2 S[1] = {make_float2(0.f, 0.f)};
#pragma unroll
  for (int s2 = 0; s2 < NCHUNK; ++s2) {
    const int c2 = dir ? (s2 < 2 ? 1 - s2 : 19 - s2) : s2;
#pragma unroll
    for (int j = 0; j < 1; ++j) {
      __hip_atomic_store((unsigned*)(obase + (size_t)c2 * 2 * 4096 + j * 512), pack2(S[j].x, S[j].y), __ATOMIC_RELAXED,
                         __HIP_MEMORY_SCOPE_AGENT);
      S[j].x = S[j].x * cd + v[j][s2].x;
      S[j].y = S[j].y * cd + v[j][s2].y;
    }
  }
  asm volatile("s_waitcnt vmcnt(0)" ::: "memory");
  __syncthreads();
  if (tid == 0) (void)xb_add(&p.bar[XCD_BAR_WORDS + layer * 32 + bh], 1u);
}

#define SLD 72
__device__ void task_retout(const Params& p, int layer, int b, int hd, int c, unsigned char* smem) {
  const int tid = otid(), lane = tid & 63, wave = tid >> 6, r = lane & 31, h = lane >> 5;
  bfraw* sV = (bfraw*)smem;
  bfraw* sSf = sV + 64 * TLD;
  bfraw* sSb = sSf + 64 * SLD;
  const int R0 = chunk_row0(b, c);
  const float lgf = log2_sigmoid(p.dec_f[layer * 4 + hd]);
  const float lgb = log2_sigmoid(p.dec_b[layer * 4 + hd]);
  const float cdf = exp2f(lgf * 128.f), cdb = exp2f(lgb * 128.f);
  __syncthreads();
  {
    const int tok = tid >> 1, d0 = (tid & 1) * 32;
    const bfraw* vp = p.P + (size_t)(R0 + tok) * INC + C_RV + hd * 64 + d0;
#pragma unroll
    for (int i = 0; i < 4; ++i) {
      uint4 vu = *(const uint4*)(vp + i * 8);
      unsigned vw[4] = {vu.x, vu.y, vu.z, vu.w};
#pragma unroll
      for (int j = 0; j < 4; ++j) {
        const int d = d0 + i * 8 + j * 2;
        sV[d * TLD + tok] = (bfraw)(vw[j] & 0xffffu);
        sV[(d + 1) * TLD + tok] = (bfraw)(vw[j] >> 16);
      }
    }
  }
  {
    unsigned* rdy = &p.bar[XCD_BAR_WORDS + layer * 32 + b * 4 + hd];
    if (tid == 0) {
      XB_SPIN(xb_ld(rdy) < 16u, p.bar);
    }
    __syncthreads();
    const bfraw* pf = p.PRE + ((((size_t)b * 4 + hd) * NCHUNK + c) * 2) * 4096;
#pragma unroll
    for (int j = 0; j < 2; ++j) {
      const int e0 = (tid + 256 * j) * 8;
      const int dk = e0 >> 6, dv0 = e0 & 63;
      const unsigned long long f0 = __hip_atomic_load((unsigned long long*)(pf + e0), __ATOMIC_RELAXED, __HIP_MEMORY_SCOPE_AGENT);
      const unsigned long long f1 = __hip_atomic_load((unsigned long long*)(pf + e0 + 4), __ATOMIC_RELAXED, __HIP_MEMORY_SCOPE_AGENT);
      const unsigned long long b0 = __hip_atomic_load((unsigned long long*)(pf + 4096 + e0), __ATOMIC_RELAXED, __HIP_MEMORY_SCOPE_AGENT);
      const unsigned long long b1 = __hip_atomic_load((unsigned long long*)(pf + 4096 + e0 + 4), __ATOMIC_RELAXED, __HIP_MEMORY_SCOPE_AGENT);
      unsigned wf[4] = {(unsigned)f0, (unsigned)(f0 >> 32), (unsigned)f1, (unsigned)(f1 >> 32)};
      unsigned wb[4] = {(unsigned)b0, (unsigned)(b0 >> 32), (unsigned)b1, (unsigned)(b1 >> 32)};
#pragma unroll
      for (int q = 0; q < 4; ++q) {
        sSf[(dv0 + 2 * q) * SLD + dk] = (bfraw)(wf[q] & 0xffffu);
        sSf[(dv0 + 2 * q + 1) * SLD + dk] = (bfraw)(wf[q] >> 16);
        sSb[(dv0 + 2 * q) * SLD + dk] = (bfraw)(wb[q] & 0xffffu);
        sSb[(dv0 + 2 * q + 1) * SLD + dk] = (bfraw)(wb[q] >> 16);
      }
    }
  }
  const int qi = wave * 32 + r;
  Frag qf[4];
  {
    const bfraw* qp = p.P + (size_t)(R0 + qi) * INC + C_RQ + hd * 64 + h * 8;
#pragma unroll
    for (int ks = 0; ks < 4; ++ks) qf[ks].u = *(const uint4*)(qp + ks * 16);
  }
  __syncthreads();
  f32x16 o0, o1;
  {
    f32x16 x0 = zero16(), x1 = zero16();
#pragma unroll
    for (int ks = 0; ks < 4; ++ks) {
      Frag a0, a1;
      a0.u = *(const uint4*)(sSf + r * SLD + ks * 16 + h * 8);
      a1.u = *(const uint4*)(sSf + (32 + r) * SLD + ks * 16 + h * 8);
      x0 = mfma32(a0, qf[ks], x0);
      x1 = mfma32(a1, qf[ks], x1);
    }
    const float sf = exp2f(lgf * (float)(qi + 1));
#pragma unroll
    for (int i = 0; i < 16; ++i) {
      o0[i] = x0[i] * sf;
      o1[i] = x1[i] * sf;
    }
    x0 = zero16();
    x1 = zero16();
#pragma unroll
    for (int ks = 0; ks < 4; ++ks) {
      Frag a0, a1;
      a0.u = *(const uint4*)(sSb + r * SLD + ks * 16 + h * 8);
      a1.u = *(const uint4*)(sSb + (32 + r) * SLD + ks * 16 + h * 8);
      x0 = mfma32(a0, qf[ks], x0);
      x1 = mfma32(a1, qf[ks], x1);
    }
    const float sb = exp2f(lgb * (float)(128 - qi));
#pragma unroll
    for (int i = 0; i < 16; ++i) {
      o0[i] += x0[i] * sb;
      o1[i] += x1[i] * sb;
    }
  }
#pragma unroll 1
  for (int kt = 0; kt < 4; ++kt) {
    f32x16 s = zero16();
    const bfraw* kp = p.P + (size_t)(R0 + kt * 32 + r) * INC + C_RK + hd * 64 + h * 8;
#pragma unroll
    for (int ks = 0; ks < 4; ++ks) {
      Frag a;
      a.u = *(const uint4*)(kp + ks * 16);
      s = mfma32(a, qf[ks], s);
    }
#pragma unroll
    for (int reg = 0; reg < 16; ++reg) {
      const int j = kt * 32 + (reg & 3) + 8 * (reg >> 2) + 4 * h;
      const int d = qi - j;
      const float w = fexp2(d >= 0 ? lgf * (float)d : lgb * (float)(-d));
      s[reg] *= w;
    }
#pragma unroll
    for (int s2 = 0; s2 < 2; ++s2) {
      Frag pb, v0, v1;
      pb.w[0] = pack2(s[8 * s2 + 0], s[8 * s2 + 1]);
      pb.w[1] = pack2(s[8 * s2 + 2], s[8 * s2 + 3]);
      pb.w[2] = pack2(s[8 * s2 + 4], s[8 * s2 + 5]);
      pb.w[3] = pack2(s[8 * s2 + 6], s[8 * s2 + 7]);
      const int ko = kt * 32 + s2 * 16 + h * 4;
      v0.d[0] = *(const uint2*)(sV + r * TLD + ko);
      v0.d[1] = *(const uint2*)(sV + r * TLD + ko + 8);
      v1.d[0] = *(const uint2*)(sV + (32 + r) * TLD + ko);
      v1.d[1] = *(const uint2*)(sV + (32 + r) * TLD + ko + 8);
      o0 = mfma32(v0, pb, o0);
      o1 = mfma32(v1, pb, o1);
    }
  }
  float sm_ = 0.f;
#pragma unroll
  for (int i = 0; i < 16; ++i) sm_ += o0[i] + o1[i];
  sm_ = xhalf_sum(sm_);
  const float mu = sm_ * (1.f / 64.f);
  float q = 0.f;
#pragma unroll
  for (int i = 0; i < 16; ++i) {
    float d0 = o0[i] - mu, d1 = o1[i] - mu;
    q += d0 * d0 + d1 * d1;
  }
  q = xhalf_sum(q);
  const float rstd = rsqrtf(q * (1.f / 64.f) + EPSF);
  const size_t row = (size_t)R0 + qi;
  const bfraw* gp = p.P + row * INC + C_GRET + hd * 64;
  bfraw* op = p.U + row * DM + 512 + hd * 64;
  const float* gg = p.gn_g + layer * 256 + hd * 64;
  const float* gb = p.gn_b + layer * 256 + hd * 64;
#pragma unroll
  for (int dt = 0; dt < 2; ++dt) {
#pragma unroll
    for (int g = 0; g < 4; ++g) {
      const int d = dt * 32 + 8 * g + 4 * h;
      uint2 gu = *(const uint2*)(gp + d);
      float4 g4 = *(const float4*)(gg + d);
      float4 b4 = *(const float4*)(gb + d);
      float x0 = ((dt ? o1[g * 4 + 0] : o0[g * 4 + 0]) - mu) * rstd * g4.x + b4.x;
      float x1 = ((dt ? o1[g * 4 + 1] : o0[g * 4 + 1]) - mu) * rstd * g4.y + b4.y;
      float x2 = ((dt ? o1[g * 4 + 2] : o0[g * 4 + 2]) - mu) * rstd * g4.z + b4.z;
      float x3 = ((dt ? o1[g * 4 + 3] : o0[g * 4 + 3]) - mu) * rstd * g4.w + b4.w;
      x0 *= siluf(lo_bf(gu.x));
      x1 *= siluf(hi_bf(gu.x));
      x2 *= siluf(lo_bf(gu.y));
      x3 *= siluf(hi_bf(gu.y));
      *(uint2*)(op + d) = make_uint2(pack2(x0, x1), pack2(x2, x3));
    }
  }
}

__device__ void phase3(const Params& p, int layer, unsigned char* smem) {
  const bool need_ctx = (layer == 0);
  const int n_pf = 512;
  const int n_at = NB * 8 * 16 + (need_ctx ? NB * 8 * 2 : 0);
  const int n_rt = NB * 4 * (need_ctx ? 18 : 16);
  const int total = n_pf + n_at + n_rt;
  for (int t0_ = blockIdx.x; t0_ < total; t0_ += gridDim.x) {
    if (t0_ < n_pf) {
      task_prefix(p, layer, t0_);
      continue;
    }
    const int t1_ = t0_ - n_pf;
    const int t = t1_ < NB * 8 * 16 ? xcd_remap(t1_, NB * 8 * 16) : t1_;
    if (t < NB * 8 * 16) {
      const int qb = t & 15, bh = t >> 4;
      task_attn(p, bh >> 3, bh & 7, CTX + qb * 128, LKEYS, smem);
    } else if (t < n_at) {
      const int tt = t - NB * 8 * 16;
      const int qb = tt & 1, bh = tt >> 1;
      task_attn(p, bh >> 3, bh & 7, qb * 128, CTX, smem);
    } else {
      const int tt = t - n_at;
      const int nc = need_ctx ? 18 : 16;
      const int c = tt % nc + (need_ctx ? 0 : 2);
      const int bh = tt / nc;
      task_retout(p, layer, bh >> 2, bh & 3, c, smem);
    }
  }
}

__device__ void phase4(const Params& p, int layer, unsigned char* smem) {
  const int tid = otid();
  const int MT = (layer == 0 ? NROW : NLAT) / 128, NT = 8;
  const bfraw* W = p.wt_out + (size_t)layer * 1024 * 1024;
  bfraw* Y = p.P;
  bfraw* sT = (bfraw*)smem;
  for (int t0_ = blockIdx.x; t0_ < MT * NT; t0_ += gridDim.x) {
    const int t = xcd_remap(t0_, MT * NT);
    const int mt = t / NT, nt = t % NT;
    const int m0 = mt * 128, n0 = nt * 128;
    f32x16 acc[4];
    gemm128<true, 1024>(p.U + (size_t)m0 * DM, DM, W, n0 >> 5, (bfraw*)smem, acc);
    stage_tile<true>(sT, acc);
    __syncthreads();
#pragma unroll 2
    for (int i = 0; i < 8; ++i) {
      const int chunk = tid + 256 * i;
      const int row = chunk >> 4, cc = (chunk & 15) * 8;
      *(uint4*)(Y + (size_t)(m0 + row) * DM + n0 + cc) = *(const uint4*)(sT + row * ELD + cc);
    }
    __syncthreads();
  }
}


#ifdef ONLY
#define EN(n) ((n) == ONLY)
#else
#define EN(n) true
#endif
__global__ void __launch_bounds__(256, 2) mega(Params p) {
  extern __shared__ __attribute__((aligned(16))) unsigned char smem_dyn[];
  unsigned char* smem = smem_dyn + 16;
  uint4& xb_words = *(uint4*)smem_dyn;
  cg::grid_group grid = cg::this_grid();
  if (threadIdx.x == 0) xb_words = make_uint4(0u, 0u, 0u, 0u);
  __syncthreads();
  XcdBarrier xb = xcd_barrier_post(p.bar, (volatile LAS unsigned*)&xb_words);
  if (p.phase_begin < 0) grid.sync();
  for (int ph = p.phase_begin; ph < p.phase_end; ++ph) {
    if (ph > p.phase_begin) xcd_barrier(xb);
    if (ph == 0) { if (EN(0)) phase0a(p, smem, 0); }
    else if (ph == 1) { if (EN(1)) { phase0a(p, smem, 1); phase_rows(p, 0, true); } }
    else {
      const int layer = (ph - 2) / 5, sub = (ph - 2) % 5;
      if (sub == 0) { if (EN(2)) phase1(p, layer, smem); }
      else if (sub == 1) { if (EN(3)) phase2(p, layer, smem); }
      else if (sub == 2) { if (EN(4)) phase3(p, layer, smem); }
      else if (sub == 3) { if (EN(5)) phase4(p, layer, smem); }
      else { if (EN(6)) phase_rows(p, layer, false); }
    }
  }
}

extern "C" void kernel_launch(void* const* d_in, const int* in_sizes, int n_in, void* d_out, int out_size, void* d_ws,
                              size_t ws_size, hipStream_t stream) {
  static int grid_blocks = 0;
  if (!grid_blocks) {
    int dev = 0, cus = 0, per_cu = 0;
    hipGetDevice(&dev);
    hipDeviceGetAttribute(&cus, hipDeviceAttributeMultiprocessorCount, dev);
    hipFuncSetAttribute((const void*)mega, hipFuncAttributeMaxDynamicSharedMemorySize, DYN_LDS);
    hipOccupancyMaxActiveBlocksPerMultiprocessor(&per_cu, mega, 256, DYN_LDS);
    if (per_cu > 2) per_cu = 2;
    if (per_cu < 1) per_cu = 1;
    grid_blocks = cus * per_cu;
  }
  Params p{};
  const float* const* in = (const float* const*)d_in;
  p.x = in[0]; p.c = in[1]; p.ctx = in[2]; p.c_ctx = in[3]; p.w_mod = in[4]; p.b_mod = in[5]; p.w_in = in[6];
  p.g_q = in[7]; p.w_uq = in[8]; p.g_kv = in[9]; p.w_ukv = in[10]; p.dec_f = in[11]; p.dec_b = in[12];
  p.gn_g = in[13]; p.gn_b = in[14]; p.dw = in[15]; p.dw_b = in[16]; p.cln_g = in[17]; p.cln_b = in[18];
  p.pw = in[19]; p.pw_b = in[20]; p.w_out = in[21]; p.ln_g = in[22]; p.ln_b = in[23];
  p.out = (float*)d_out;
  size_t off = 0;
  auto take = [&](size_t bytes) {
    void* q = (char*)d_ws + off;
    off += (bytes + 255) & ~(size_t)255;
    return q;
  };
  p.wt_in = (bfraw*)take((size_t)2 * INCP * 1024 * 2);
  p.wt_uq = (bfraw*)take((size_t)2 * 768 * 256 * 2);
  p.wt_ukv = (bfraw*)take((size_t)2 * 1024 * 128 * 2);
  p.wt_pw = (bfraw*)take((size_t)2 * 256 * 256 * 2);
  p.wt_out = (bfraw*)take((size_t)2 * 1024 * 1024 * 2);
  p.mod = (float*)take((size_t)2 * 9 * 3072 * 4);
  p.tabA = (float2*)take(64 * 8 * 8);
  p.tabB = (float2*)take(64 * 16 * 8);
  p.U = (bfraw*)take((size_t)NROW * DM * 2);
  p.P = (bfraw*)take((size_t)NROW * INC * 2);
  p.Q = (bfraw*)take((size_t)NB * 8 * LKEYS * 96 * 2);
  p.KN = (bfraw*)take((size_t)NB * 8 * LKEYS * 64 * 2);
  p.VT = (bfraw*)take((size_t)NB * 8 * 64 * LKEYS * 2);
  p.CST = (float*)take((size_t)NB * 4 * NCHUNK * 2 * 4096 * 4);
  p.HC1 = (float*)take((size_t)NCTX * DM * 4);
  p.bar = (unsigned*)take((size_t)(XCD_BAR_WORDS + 64) * 4);
  p.KR = (bfraw*)take((size_t)NB * LKEYS * 32 * 2);
  p.PRE = (bfraw*)take((size_t)NB * 4 * NCHUNK * 2 * 4096 * 2);
  if (off > ws_size) {
    fprintf(stderr, "workspace too small: need %zu have %zu\n", off, ws_size);
    return;
  }
  hipMemsetAsync(p.bar, 0, (size_t)(XCD_BAR_WORDS + 64) * 4, stream);
#if ONE_LAUNCH
  p.phase_begin = 0;
  p.phase_end = NPHASE;
  void* args[] = {&p};
  hipError_t e = hipLaunchCooperativeKernel((void*)mega, dim3(grid_blocks), dim3(256), args, DYN_LDS, stream);
  if (e != hipSuccess) fprintf(stderr, "cooperative launch failed: %s (grid %d)\n", hipGetErrorString(e), grid_blocks);
#else
  for (int ph = 0; ph < NPHASE; ++ph) {
    p.phase_begin = ph;
    p.phase_end = ph + 1;
    hipLaunchKernelGGL(mega, dim3(grid_blocks), dim3(256), DYN_LDS, stream, p);
  }
#endif
}
```

```cpp
#include <hip/hip_runtime.h>
#include <hip/hip_cooperative_groups.h>
#include <cstdio>
#include <cstdint>
namespace cg = cooperative_groups;

#ifndef ONE_LAUNCH
#define ONE_LAUNCH 1
#endif

typedef unsigned short bfraw;
typedef __attribute__((ext_vector_type(8))) __bf16 bf16x8;
typedef __attribute__((ext_vector_type(16))) float f32x16;

#define DM 1024
#define NB 8
#define SEQ 2048
#define CTX 256
#define NLAT (NB * SEQ)
#define NCTX (NB * CTX)
#define NROW (NLAT + NCTX)
#define INC 2720
#define INCP 2816
#define LKEYS 2304
#define C_PQ 0
#define C_PKV 256
#define C_PKR 384
#define C_GMLA 416
#define C_RQ 928
#define C_RK 1184
#define C_RV 1440
#define C_GRET 1696
#define C_GLU 1952
#define C_GCONV 2464
#define NCHUNK 18
#define EPSF 1e-5f
#define ALPHA_F 1.4142135623730951f
#define NPHASE 12
#define DYN_LDS (16 + 31744 + 32768)

struct Params {
  const float *x, *c, *ctx, *c_ctx, *w_mod, *b_mod, *w_in, *g_q, *w_uq, *g_kv, *w_ukv, *dec_f, *dec_b, *gn_g, *gn_b,
      *dw, *dw_b, *cln_g, *cln_b, *pw, *pw_b, *w_out, *ln_g, *ln_b;
  float* out;
  bfraw *wt_in, *wt_uq, *wt_ukv, *wt_pw, *wt_out;
  float* mod;
  float2* tabA;
  float2* tabB;
  bfraw* U;
  bfraw* P;
  bfraw *Q, *KN, *VT;
  float* CST;
  float* HC1;
  unsigned* bar;
  bfraw* KR;
  bfraw* PRE;
  int phase_begin, phase_end;
};

typedef __attribute__((ext_vector_type(2))) float f2v;
typedef __attribute__((ext_vector_type(2))) __bf16 bf2v;
__device__ __forceinline__ unsigned pack2(float a, float b) {
  f2v v = {a, b};
  bf2v r = __builtin_convertvector(v, bf2v);
  return __builtin_bit_cast(unsigned, r);
}
__device__ __forceinline__ bfraw f2bf(float f) { return (bfraw)(pack2(f, 0.f) & 0xffffu); }
__device__ __forceinline__ float bf2f(bfraw b) { return __uint_as_float(((unsigned)b) << 16); }
__device__ __forceinline__ float lo_bf(unsigned u) { return __uint_as_float(u << 16); }
__device__ __forceinline__ float hi_bf(unsigned u) { return __uint_as_float(u & 0xffff0000u); }
__device__ __forceinline__ float siluf(float x) { return x * __builtin_amdgcn_rcpf(1.0f + __expf(-x)); }
__device__ __forceinline__ float sigmf(float x) { return __builtin_amdgcn_rcpf(1.0f + __expf(-x)); }

__device__ __forceinline__ int otid() {
  int t = threadIdx.x;
  asm volatile("" : "+v"(t));
  return t;
}

union Frag {
  bf16x8 v;
  uint4 u;
  uint2 d[2];
  unsigned w[4];
};

__device__ __forceinline__ f32x16 mfma32(const Frag& a, const Frag& b, f32x16 c) {
  return __builtin_amdgcn_mfma_f32_32x32x16_bf16(a.v, b.v, c, 0, 0, 0);
}
__device__ __forceinline__ f32x16 zero16() {
  f32x16 z;
#pragma unroll
  for (int i = 0; i < 16; ++i) z[i] = 0.f;
  return z;
}
__device__ __forceinline__ float wave_sum(float v) {
#pragma unroll
  for (int o = 32; o > 0; o >>= 1) v += __shfl_xor(v, o);
  return v;
}

#define XB_TMO      128
#define XB_XCNT(j)  (256  + 64 * (j))
#define XB_XSUB(j)  (1280 + 64 * (j))
#define XB_XGEN(j)  (2304 + 64 * (j))
#define XB_TOP      3328
#define XB_TOPGEN   3392
#define XCD_BAR_WORDS 3456
#define XB_SPIN_CAP (1u << 22)
#define LAS __attribute__((address_space(3)))
__device__ __forceinline__ unsigned xb_ld(unsigned* p) { return __hip_atomic_load(p, __ATOMIC_RELAXED, __HIP_MEMORY_SCOPE_AGENT); }
__device__ __forceinline__ unsigned xb_add(unsigned* p, unsigned v) { return __hip_atomic_fetch_add(p, v, __ATOMIC_RELAXED, __HIP_MEMORY_SCOPE_AGENT); }
__device__ __forceinline__ unsigned xb_xcc_id() { return (unsigned)__builtin_amdgcn_s_getreg((3 << 11) | 20) & 0xFu; }
#define XB_SPIN(cond, bar) do { unsigned _sp = 0; while (cond) { __builtin_amdgcn_s_sleep(1); \
    if ((++_sp & 255u) == 0u) { if (xb_ld(&(bar)[XB_TMO])) break; if (_sp > XB_SPIN_CAP) { atomicAdd(&(bar)[XB_TMO], 1u); break; } } } } while (0)
struct XcdBarrier {
  unsigned* bar;
  unsigned x;
  volatile LAS unsigned* st;
};
__device__ __forceinline__ XcdBarrier xcd_barrier_post(unsigned* bar, volatile LAS unsigned* st) {
  XcdBarrier b;
  b.bar = bar;
  b.x = xb_xcc_id();
  b.st = st;
  if (threadIdx.x == 0) (void)xb_add(&bar[XB_XCNT(b.x)], 1u);
  return b;
}
__device__ __forceinline__ void xcd_barrier_complete(unsigned* bar, unsigned x, unsigned& nloc, unsigned& nx) {
  const unsigned G = gridDim.x * gridDim.y * gridDim.z;
  unsigned sum, cnt, mine, sp = 0u;
  for (;;) {
    sum = 0u; cnt = 0u; mine = 0u;
#pragma unroll
    for (unsigned j = 0; j < 16; ++j) {
      const unsigned c = xb_ld(&bar[XB_XCNT(j)]);
      sum += c;
      cnt += (c > 0u) ? 1u : 0u;
      mine = (j == x) ? c : mine;
    }
    if (sum == G) break;
    __builtin_amdgcn_s_sleep(1);
    if ((++sp & 255u) == 0u) {
      if (xb_ld(&bar[XB_TMO])) break;
      if (sp > XB_SPIN_CAP) { atomicAdd(&bar[XB_TMO], 1u); break; }
    }
  }
  nloc = mine > 0u ? mine : 1u;
  nx = cnt > 0u ? cnt : 1u;
}
__device__ __forceinline__ void xcd_barrier(const XcdBarrier& b) {
  asm volatile("s_waitcnt vmcnt(0)" ::: "memory");
  __syncthreads();
  if (threadIdx.x == 0) {
    unsigned* bar = b.bar;
    __builtin_amdgcn_s_waitcnt(0);
    unsigned nloc = b.st[0], nx = b.st[1];
    if (nloc == 0u) { xcd_barrier_complete(bar, b.x, nloc, nx); b.st[0] = nloc; b.st[1] = nx; }
    const unsigned old = xb_add(&bar[XB_XSUB(b.x)], 1u);
    const unsigned gen = old / nloc;
    if (old + 1u == (gen + 1u) * nloc) {
      __builtin_amdgcn_fence(__ATOMIC_RELEASE, "agent");
      asm volatile("s_waitcnt vmcnt(0)" ::: "memory");
      const unsigned og = xb_add(&bar[XB_TOP], 1u);
      const unsigned tg = og / nx;
      if (og + 1u == (tg + 1u) * nx) xb_add(&bar[XB_TOPGEN], 1u);
      else XB_SPIN(xb_ld(&bar[XB_TOPGEN]) == tg, bar);
      __builtin_amdgcn_fence(__ATOMIC_ACQUIRE, "agent");
      xb_add(&bar[XB_XGEN(b.x)], 1u);
      asm volatile("s_waitcnt vmcnt(0)" ::: "memory");
    } else {
      XB_SPIN(xb_ld(&bar[XB_XGEN(b.x)]) == gen, bar);
      __builtin_amdgcn_fence(__ATOMIC_ACQUIRE, "agent");
      asm volatile("s_waitcnt vmcnt(0)" ::: "memory");
    }
  }
  __syncthreads();
}


#define GLD 72
#define GEMM_LDS (2 * 128 * GLD * 2)
template <bool TRANS, int K>
__device__ __forceinline__ void gemm128(const bfraw* __restrict__ A, int lda, const bfraw* __restrict__ Bsw, int nt32_0,
                                        bfraw* sm, f32x16 (&acc)[4]) {
  const int tid = otid(), lane = tid & 63, wave = tid >> 6, r = lane & 31, h = lane >> 5;
  constexpr int KS = K >> 4;
  constexpr int nk = K >> 6;
  bfraw* sA = sm;
  const int lr = tid >> 3, lc = (tid & 7) * 8;
  const bfraw* ga = A + (size_t)lr * lda + lc;
  const bfraw* gb0 = Bsw + ((size_t)(nt32_0 + wave) * KS * 64 + lane) * 8;
  uint4 pa0, pa1, pa2, pa3, qa0, qa1, qa2, qa3;
  Frag bf[2][4];
#define GL(S)                                              \
  S##a0 = *(const uint4*)(ga);                             \
  S##a1 = *(const uint4*)(ga + (size_t)32 * lda);          \
  S##a2 = *(const uint4*)(ga + (size_t)64 * lda);          \
  S##a3 = *(const uint4*)(ga + (size_t)96 * lda);
#define SL(S, buf)                                                         \
  *(uint4*)(sA + (buf) * 128 * GLD + lr * GLD + lc) = S##a0;              \
  *(uint4*)(sA + (buf) * 128 * GLD + (lr + 32) * GLD + lc) = S##a1;       \
  *(uint4*)(sA + (buf) * 128 * GLD + (lr + 64) * GLD + lc) = S##a2;       \
  *(uint4*)(sA + (buf) * 128 * GLD + (lr + 96) * GLD + lc) = S##a3;
#define BL(set, kt_)                                                                       \
  _Pragma("unroll") for (int ks = 0; ks < 4; ++ks) {                                       \
    bf[set][ks].u = *(const uint4*)(gb0 + (size_t)((kt_) * 4 + ks) * 512);                 \
  }
#define COMPUTE(buf, set)                                                         \
  {                                                                               \
    const bfraw* cA = sA + (buf) * 128 * GLD + r * GLD + h * 8;                   \
    _Pragma("unroll") for (int ks = 0; ks < 4; ++ks) {                            \
      _Pragma("unroll") for (int mi = 0; mi < 4; ++mi) {                          \
        Frag a0;                                                                  \
        a0.u = *(const uint4*)(cA + mi * 32 * GLD + ks * 16);                     \
        if (TRANS) acc[mi] = mfma32(bf[set][ks], a0, acc[mi]);                    \
        else acc[mi] = mfma32(a0, bf[set][ks], acc[mi]);                          \
      }                                                                           \
    }                                                                             \
  }
  GL(p)
  BL(0, 0)
  ga += 64;
  GL(q)
#pragma unroll
  for (int i = 0; i < 4; ++i) acc[i] = zero16();
  SL(p, 0)
  __syncthreads();
#pragma unroll
  for (int kt = 0; kt < nk; kt += 2) {
    if (kt + 2 < nk) {
      ga += 64;
      GL(p)
    }
    BL(1, kt + 1)
    COMPUTE(0, 0)
    SL(q, 1)
    __syncthreads();
    if (kt + 3 < nk) {
      ga += 64;
      GL(q)
    }
    if (kt + 2 < nk) {
      BL(0, kt + 2)
    }
    COMPUTE(1, 1)
    if (kt + 2 < nk) {
      SL(p, 0)
    }
    __syncthreads();
  }
#undef GL
#undef SL
#undef BL
#undef COMPUTE
}


#define ELD 136
template <bool TRANS>
__device__ __forceinline__ void stage_tile(bfraw* sT, const f32x16 (&acc)[4]) {
  const int tid_ = otid(); const int lane = tid_ & 63, wave = tid_ >> 6, r = lane & 31, h = lane >> 5;
#pragma unroll
  for (int mi = 0; mi < 4; ++mi)
#pragma unroll
    for (int g = 0; g < 4; ++g) {
      const int lrow = TRANS ? (mi * 32 + r) : (wave * 32 + r);
      const int lcol = TRANS ? (wave * 32 + 8 * g + 4 * h) : (mi * 32 + 8 * g + 4 * h);
      *(uint2*)(sT + lrow * ELD + lcol) =
          make_uint2(pack2(acc[mi][4 * g + 0], acc[mi][4 * g + 1]), pack2(acc[mi][4 * g + 2], acc[mi][4 * g + 3]));
    }
}

__device__ __forceinline__ int xcd_remap(int t, int T) { return (T & 7) ? t : (t & 7) * (T >> 3) + (t >> 3); }

__device__ __forceinline__ void grouped_tile(int t, int MT, int NT, int& mt, int& nt) {
  const int nig = 8 * NT, gid = t / nig, fm = gid * 8, gsz = min(MT - fm, 8), rem = t - gid * nig;
  mt = fm + rem % gsz;
  nt = rem / gsz;
}

__device__ __forceinline__ void rowinfo(int row, int& b, int& kpos, int& l, bool& isctx) {
  if (row < NLAT) {
    b = row >> 11;
    l = row & 2047;
    kpos = CTX + l;
    isctx = false;
  } else {
    int r2 = row - NLAT;
    b = r2 >> 8;
    l = r2 & 255;
    kpos = l;
    isctx = true;
  }
}
__device__ __forceinline__ int keyrow(int b, int kpos) { return kpos < CTX ? NLAT + b * CTX + kpos : b * SEQ + (kpos - CTX); }

__device__ void conv_weight_tile(const float* __restrict__ src, int Ksz, int Nsz, bfraw* __restrict__ dst, int kt, int nt,
                                 const float* __restrict__ kscale, float* sT, bool kvperm = false) {
  const int tid = otid();
  __syncthreads();
#pragma unroll
  for (int i = 0; i < 4; ++i) {
    const int idx = tid + 256 * i;
    const int k = idx >> 4, n4 = (idx & 15) * 4;
    const int gk = kt * 64 + k, gn = nt * 64 + n4;
    float4 v = make_float4(0.f, 0.f, 0.f, 0.f);
    if (gn < Nsz) {
      v = *(const float4*)(src + (size_t)gk * Nsz + gn);
      if (kscale) {
        const float sc = kscale[gk];
        v.x *= sc; v.y *= sc; v.z *= sc; v.w *= sc;
      }
    }
    *(float4*)(sT + k * 68 + n4) = v;
  }
  __syncthreads();
#pragma unroll
  for (int i = 0; i < 2; ++i) {
    const int o = tid + 256 * i;
    const int n = o & 63, ko = o >> 6;
    const float* c = sT + (ko * 8) * 68 + n;
    uint4 w;
    w.x = pack2(c[0 * 68], c[1 * 68]);
    w.y = pack2(c[2 * 68], c[3 * 68]);
    w.z = pack2(c[4 * 68], c[5 * 68]);
    w.w = pack2(c[6 * 68], c[7 * 68]);
    int gn = nt * 64 + n;
    if (kvperm) gn = ((gn >> 6) & 1) * 512 + (gn >> 7) * 64 + (gn & 63);
    const int gk0 = kt * 64 + ko * 8;
    *(uint4*)(dst + ((((size_t)(gn >> 5) * (Ksz >> 4) + (gk0 >> 4)) * 64) + ((gk0 >> 3) & 1) * 32 + (gn & 31)) * 8) = w;
  }
}

__device__ void phase0a(const Params& p, unsigned char* smem, int part) {
  const int tid = otid();
  float* sf = (float*)smem;
  const int T_MOD = 192;
  const int T_IN = 16 * 44, T_OUT = 16 * 16, T_UQ = 4 * 12, T_UKV = 2 * 16, T_PW = 4 * 4;
  const int T_W = T_IN + T_OUT + T_UQ + T_UKV + T_PW;
  const bool split = gridDim.x > (unsigned)(T_MOD + 64);
  if (part == 1 && split) return;
  const int total = (part == 0 && !split) ? T_MOD : T_MOD + 2 * T_W + 1;
  int tstart, tstep;
  if (part == 0 && split) {
    if ((int)blockIdx.x < T_MOD) { tstart = blockIdx.x; tstep = 1 << 30; }
    else { tstart = T_MOD + ((int)blockIdx.x - T_MOD); tstep = (int)gridDim.x - T_MOD; }
  } else {
    tstart = blockIdx.x + (part == 0 ? 0 : T_MOD);
    tstep = gridDim.x;
  }
  for (int t = tstart; t < total && t >= 0; t = (tstep == (1 << 30)) ? total : t + tstep) {
    if (t < T_MOD) {
      const int l = t / 96, jt = t % 96;
      __syncthreads();
      for (int i = tid; i < 9 * 1024; i += 256) {
        int rr = i >> 10, k = i & 1023;
        float cv = rr < 8 ? p.c[rr * 1024 + k] : p.c_ctx[k];
        sf[i] = siluf(cv);
      }
      __syncthreads();
      const int col = tid & 31, kg = tid >> 5;
      float a[9];
#pragma unroll
      for (int rr = 0; rr < 9; ++rr) a[rr] = 0.f;
      const float* w = p.w_mod + (size_t)l * 1024 * 3072 + jt * 32 + col;
      for (int kb = kg * 128; kb < kg * 128 + 128; kb += 16) {
        float wv[16];
#pragma unroll
        for (int u = 0; u < 16; ++u) wv[u] = w[(size_t)(kb + u) * 3072];
#pragma unroll
        for (int u = 0; u < 16; ++u)
#pragma unroll
          for (int rr = 0; rr < 9; ++rr) a[rr] += sf[rr * 1024 + kb + u] * wv[u];
      }
      float* sR = sf + 9 * 1024;
#pragma unroll
      for (int rr = 0; rr < 9; ++rr) sR[(kg * 9 + rr) * 32 + col] = a[rr];
      __syncthreads();
      for (int i = tid; i < 288; i += 256) {
        int rr = i >> 5, cc = i & 31;
        float s = 0.f;
        for (int g = 0; g < 8; ++g) s += sR[(g * 9 + rr) * 32 + cc];
        s += p.b_mod[l * 3072 + jt * 32 + cc];
        p.mod[((size_t)l * 9 + rr) * 3072 + jt * 32 + cc] = s;
      }
    } else if (t < T_MOD + 2 * T_W) {
      int tt = t - T_MOD;
      const int l = tt / T_W;
      tt %= T_W;
      if (tt < T_IN) {
        conv_weight_tile(p.w_in + (size_t)l * 1024 * INC, 1024, INC, p.wt_in + (size_t)l * INCP * 1024, tt / 44, tt % 44, nullptr, sf);
      } else if ((tt -= T_IN) < T_OUT) {
        conv_weight_tile(p.w_out + (size_t)l * 1024 * 1024, 1024, 1024, p.wt_out + (size_t)l * 1024 * 1024, tt / 16, tt % 16, nullptr, sf);
      } else if ((tt -= T_OUT) < T_UQ) {
        conv_weight_tile(p.w_uq + (size_t)l * 256 * 768, 256, 768, p.wt_uq + (size_t)l * 768 * 256, tt / 12, tt % 12, p.g_q + l * 256, sf);
      } else if ((tt -= T_UQ) < T_UKV) {
        conv_weight_tile(p.w_ukv + (size_t)l * 128 * 1024, 128, 1024, p.wt_ukv + (size_t)l * 1024 * 128, tt / 16, tt % 16, p.g_kv + l * 128, sf, true);
      } else {
        tt -= T_UKV;
        conv_weight_tile(p.pw + (size_t)l * 256 * 256, 256, 256, p.wt_pw + (size_t)l * 256 * 256, tt / 4, tt % 4, nullptr, sf);
      }
    } else {
      for (int i = tid; i < 64 * 8; i += 256) {
        int pos = i >> 3, f = i & 7;
        float inv = powf(10000.0f, -(float)(2 * f) / 16.0f);
        float ang = (float)pos * inv;
        p.tabA[i] = make_float2(cosf(ang), sinf(ang));
      }
      for (int i = tid; i < 64 * 16; i += 256) {
        int pos = i >> 4, f = i & 15;
        float inv = powf(10000.0f, -(float)(2 * f) / 32.0f);
        float ang = (float)pos * inv;
        p.tabB[i] = make_float2(cosf(ang), sinf(ang));
      }
    }
  }
}

__device__ void phase_rows(const Params& p, int layer, bool is_prep) {
  const int tid_ = otid(); const int lane = tid_ & 63, wave = tid_ >> 6;
  const int gw = blockIdx.x * 4 + wave, nw = gridDim.x * 4;
  const bool last = (!is_prep) && (layer == 1);
  const int nrows = last ? NLAT : NROW;
  const bfraw* Y = p.P;
  float4 cx[4];
  uint2 cy[4];
#define ROW_XIN(rw) ((is_prep || layer == 0) ? ((rw) >= NLAT ? p.ctx + (size_t)((rw) - NLAT) * DM : p.x + (size_t)(rw) * DM) \
                                             : (const float*)p.out + (size_t)(rw) * DM)
  if (gw < nrows) {
    const float* xi = ROW_XIN(gw);
#pragma unroll
    for (int i = 0; i < 4; ++i) {
      cx[i] = *(const float4*)(xi + i * 256 + lane * 4);
      if (!is_prep) cy[i] = *(const uint2*)(Y + (size_t)gw * DM + i * 256 + lane * 4);
    }
  }
  for (int row = gw; row < nrows; row += nw) {
    int b, kpos, l;
    bool isctx;
    rowinfo(row, b, kpos, l, isctx);
    const int mrow = isctx ? 8 : b;
    float* xout = nullptr;
    if (!is_prep) xout = (layer == 0) ? (isctx ? p.HC1 + (size_t)(row - NLAT) * DM : p.out + (size_t)row * DM) : p.out + (size_t)row * DM;
    float4 nx[4];
    uint2 ny[4];
    const int nrow = row + nw;
    if (nrow < nrows) {
      const float* xi = ROW_XIN(nrow);
#pragma unroll
      for (int i = 0; i < 4; ++i) {
        nx[i] = *(const float4*)(xi + i * 256 + lane * 4);
        if (!is_prep) ny[i] = *(const uint2*)(Y + (size_t)nrow * DM + i * 256 + lane * 4);
      }
    }
    float v[16];
#pragma unroll
    for (int i = 0; i < 4; ++i) {
      v[i * 4 + 0] = cx[i].x;
      v[i * 4 + 1] = cx[i].y;
      v[i * 4 + 2] = cx[i].z;
      v[i * 4 + 3] = cx[i].w;
    }
    if (!is_prep) {
      const float* md = p.mod + ((size_t)layer * 9 + mrow) * 3072 + 2048;
      const float* lg = p.ln_g + layer * DM;
      const float* lb = p.ln_b + layer * DM;
      float s = 0.f;
#pragma unroll
      for (int i = 0; i < 4; ++i) {
        float4 g4 = *(const float4*)(md + i * 256 + lane * 4);
        const uint2 y2 = cy[i];
        v[i * 4 + 0] = ALPHA_F * v[i * 4 + 0] + g4.x * lo_bf(y2.x);
        v[i * 4 + 1] = ALPHA_F * v[i * 4 + 1] + g4.y * hi_bf(y2.x);
        v[i * 4 + 2] = ALPHA_F * v[i * 4 + 2] + g4.z * lo_bf(y2.y);
        v[i * 4 + 3] = ALPHA_F * v[i * 4 + 3] + g4.w * hi_bf(y2.y);
      }
#pragma unroll
      for (int i = 0; i < 16; ++i) s += v[i];
      float mu = wave_sum(s) * (1.0f / DM);
      float q = 0.f;
#pragma unroll
      for (int i = 0; i < 16; ++i) {
        float d = v[i] - mu;
        q += d * d;
      }
      float rstd = rsqrtf(wave_sum(q) * (1.0f / DM) + EPSF);
#pragma unroll
      for (int i = 0; i < 4; ++i) {
        float4 g4 = *(const float4*)(lg + i * 256 + lane * 4);
        float4 b4 = *(const float4*)(lb + i * 256 + lane * 4);
        v[i * 4 + 0] = (v[i * 4 + 0] - mu) * rstd * g4.x + b4.x;
        v[i * 4 + 1] = (v[i * 4 + 1] - mu) * rstd * g4.y + b4.y;
        v[i * 4 + 2] = (v[i * 4 + 2] - mu) * rstd * g4.z + b4.z;
        v[i * 4 + 3] = (v[i * 4 + 3] - mu) * rstd * g4.w + b4.w;
        *(float4*)(xout + i * 256 + lane * 4) = make_float4(v[i * 4 + 0], v[i * 4 + 1], v[i * 4 + 2], v[i * 4 + 3]);
      }
    }
    if (!last) {
      const int nl = is_prep ? 0 : layer + 1;
      const float* md = p.mod + ((size_t)nl * 9 + mrow) * 3072;
      float s = 0.f;
#pragma unroll
      for (int i = 0; i < 16; ++i) s += v[i];
      float mu = wave_sum(s) * (1.0f / DM);
      float q = 0.f;
#pragma unroll
      for (int i = 0; i < 16; ++i) {
        float d = v[i] - mu;
        q += d * d;
      }
      float rstd = rsqrtf(wave_sum(q) * (1.0f / DM) + EPSF);
#pragma unroll
      for (int i = 0; i < 4; ++i) {
        float4 sh = *(const float4*)(md + i * 256 + lane * 4);
        float4 sc = *(const float4*)(md + 1024 + i * 256 + lane * 4);
        float u0 = (v[i * 4 + 0] - mu) * rstd * (1.f + sc.x) + sh.x;
        float u1 = (v[i * 4 + 1] - mu) * rstd * (1.f + sc.y) + sh.y;
        float u2 = (v[i * 4 + 2] - mu) * rstd * (1.f + sc.z) + sh.z;
        float u3 = (v[i * 4 + 3] - mu) * rstd * (1.f + sc.w) + sh.w;
        *(uint2*)(p.U + (size_t)row * DM + i * 256 + lane * 4) = make_uint2(pack2(u0, u1), pack2(u2, u3));
      }
    }
#pragma unroll
    for (int i = 0; i < 4; ++i) {
      cx[i] = nx[i];
      cy[i] = ny[i];
    }
  }
#undef ROW_XIN
}

__device__ __forceinline__ void rope16_acc(const Params& p, f32x16& a, int l, int h) {
#pragma unroll
  for (int part = 0; part < 2; ++part) {
    const int pos = part ? (l & 63) : (l >> 6);
#pragma unroll
    for (int q = 0; q < 4; ++q) {
      const int reg = part * 8 + q;
      const float2 cs = p.tabA[pos * 8 + q + 4 * h];
      const float x1 = a[reg], x2 = a[reg + 4];
      a[reg] = x1 * cs.x - x2 * cs.y;
      a[reg + 4] = x1 * cs.y + x2 * cs.x;
    }
  }
}

__device__ void phase1(const Params& p, int layer, unsigned char* smem) {
  const int tid = otid(), lane = tid & 63, wave = tid >> 6, r = lane & 31, h = lane >> 5;
  const int wm = wave >> 1, wn = wave & 1;
  const int NT = 22, MT = NROW / 128;
  const bfraw* W = p.wt_in + (size_t)layer * INCP * 1024;
  bfraw* sT = (bfraw*)smem;
  const int n_lat = (NLAT / 128) * NT;
  const int total = layer == 0 ? MT * NT : n_lat + (NCTX / 128) * 7;
  for (int t0_ = blockIdx.x; t0_ < total; t0_ += gridDim.x) {
    const int t = xcd_remap(t0_, total);
    int mt, nt;
    if (layer == 0) {
      grouped_tile(t, MT, NT, mt, nt);
    } else if (t < n_lat) {
      grouped_tile(t, NLAT / 128, NT, mt, nt);
    } else {
      const int tt = t - n_lat, j = tt % 7;
      mt = NLAT / 128 + tt / 7;
      nt = j < 2 ? 2 + j : 7 + j;
    }
    const int m0 = mt * 128, n0 = nt * 128;
    f32x16 acc[4];
    gemm128<true, 1024>(p.U + (size_t)m0 * DM, DM, W, n0 >> 5, (bfraw*)smem, acc);
    const bool lat = m0 < NLAT;
    const int cg0 = n0 + wave * 32;
    if (lat) {
      if (cg0 >= C_RQ && cg0 < C_RV) {
        const float ksc = cg0 >= C_RK ? 0.125f : 1.0f;
        const int second = ((cg0 - C_RQ) >> 5) & 1;
#pragma unroll
        for (int mi = 0; mi < 4; ++mi) {
          const int l = (m0 + mi * 32 + r) & 2047;
          const int pos = second ? (l & 63) : (l >> 6);
#pragma unroll
          for (int reg = 0; reg < 8; ++reg) {
            const int fi = (reg & 3) + 8 * (reg >> 2) + 4 * h;
            const float2 cs = p.tabB[pos * 16 + fi];
            const float x1 = acc[mi][reg], x2 = acc[mi][reg + 8];
            acc[mi][reg] = (x1 * cs.x - x2 * cs.y) * ksc;
            acc[mi][reg + 8] = (x1 * cs.y + x2 * cs.x) * ksc;
          }
        }
      } else if (cg0 == C_PKR) {
#pragma unroll
        for (int mi = 0; mi < 4; ++mi) rope16_acc(p, acc[mi], (m0 + mi * 32 + r) & 2047, h);
      }
    } else if (cg0 >= C_RK && cg0 < C_RV) {
#pragma unroll
      for (int mi = 0; mi < 4; ++mi)
#pragma unroll
        for (int reg = 0; reg < 16; ++reg) acc[mi][reg] *= 0.125f;
    }
    stage_tile<true>(sT, acc);
    __syncthreads();
#pragma unroll 2
    for (int i = 0; i < 8; ++i) {
      const int chunk = tid + 256 * i;
      const int row = chunk >> 4, cc = (chunk & 15) * 8;
      if (n0 + cc < INC) *(uint4*)(p.P + (size_t)(m0 + row) * INC + n0 + cc) = *(const uint4*)(sT + row * ELD + cc);
    }
    __syncthreads();
  }
}

template <int NCOL>
__device__ __forceinline__ void row_rstd(const bfraw* __restrict__ src, int ld, float* sR) {
  const int tid = otid();
  const int row = tid >> 1, half = tid & 1;
  constexpr int PER = NCOL >> 1, NL = PER >> 3;
  const bfraw* s = src + (size_t)row * ld + half * PER;
  uint4 u[NL];
#pragma unroll
  for (int i = 0; i < NL; ++i) u[i] = *(const uint4*)(s + i * 8);
  float q0 = 0.f, q1 = 0.f, q2 = 0.f, q3 = 0.f;
#pragma unroll
  for (int i = 0; i < NL; ++i) {
    float a;
    a = lo_bf(u[i].x); q0 += a * a; a = hi_bf(u[i].x); q1 += a * a;
    a = lo_bf(u[i].y); q2 += a * a; a = hi_bf(u[i].y); q3 += a * a;
    a = lo_bf(u[i].z); q0 += a * a; a = hi_bf(u[i].z); q1 += a * a;
    a = lo_bf(u[i].w); q2 += a * a; a = hi_bf(u[i].w); q3 += a * a;
  }
  float q = (q0 + q1) + (q2 + q3);
  q += __shfl_xor(q, 1);
  if (half == 0) sR[row] = rsqrtf(q / (float)NCOL + EPSF);
}

__device__ void task_qup(const Params& p, int layer, int mt, int nt, unsigned char* smem) {
  const int tid = otid(), lane = tid & 63, wave = tid >> 6, r = lane & 31, h = lane >> 5;
  const int wm = wave >> 1, wn = wave & 1;
  const int m0 = mt * 128, n0 = nt * 128;
  float* sR = (float*)(smem + GEMM_LDS);
  bfraw* sT = (bfraw*)smem;
  __syncthreads();
  row_rstd<256>(p.P + (size_t)m0 * INC + C_PQ, INC, sR);
  f32x16 acc[4];
  gemm128<true, 256>(p.P + (size_t)m0 * INC + C_PQ, INC, p.wt_uq + (size_t)layer * 768 * 256, n0 >> 5, (bfraw*)smem, acc);
  const bool lat = m0 < NLAT;
  const float qs = 0.10206207261596577f * 1.4426950408889634f;
  const int ctile = (n0 + wave * 32) >> 5;
#pragma unroll
  for (int mi = 0; mi < 4; ++mi) {
    const int rl = mi * 32 + r;
    const float sc = sR[rl] * qs;
#pragma unroll
    for (int reg = 0; reg < 16; ++reg) acc[mi][reg] *= sc;
    if (lat && (ctile % 3) == 2) rope16_acc(p, acc[mi], (m0 + rl) & 2047, h);
  }
  stage_tile<true>(sT, acc);
  __syncthreads();
  int b, kpos0, l0;
  bool isctx;
  rowinfo(m0, b, kpos0, l0, isctx);
#pragma unroll 2
  for (int i = 0; i < 8; ++i) {
    const int chunk = tid + 256 * i;
    const int row = chunk >> 4, cc = (chunk & 15) * 8;
    const int c = n0 + cc;
    const int head = c / 96, d = c % 96;
    *(uint4*)(p.Q + (((size_t)b * 8 + head) * LKEYS + kpos0 + row) * 96 + d) = *(const uint4*)(sT + row * ELD + cc);
  }
}

__device__ void task_kvup(const Params& p, int layer, int mt, int nt, unsigned char* smem) {
  const int tid = otid(), lane = tid & 63, wave = tid >> 6, r = lane & 31, h = lane >> 5;
  const int wm = wave >> 1;
  const int m0 = mt * 128, n0 = nt * 128;
  float* sR = (float*)(smem + GEMM_LDS);
  bfraw* sT = (bfraw*)smem;
  __syncthreads();
  row_rstd<128>(p.P + (size_t)m0 * INC + C_PKV, INC, sR);
  f32x16 acc[4];
  int b, kpos0, l0;
  bool isctx;
  rowinfo(m0, b, kpos0, l0, isctx);
  const bfraw* A = p.P + (size_t)m0 * INC + C_PKV;
  const bfraw* W = p.wt_ukv + (size_t)layer * 1024 * 128;
  if (nt == 0) {
#pragma unroll
    for (int i = 0; i < 2; ++i) {
      const int chunk = tid + 256 * i;
      const int row = chunk >> 2, cc = (chunk & 3) * 8;
      *(uint4*)(p.KR + ((size_t)b * LKEYS + kpos0 + row) * 32 + cc) = *(const uint4*)(p.P + (size_t)(m0 + row) * INC + C_PKR + cc);
    }
  }
  if (nt < 4) {
    gemm128<true, 128>(A, INC, W, n0 >> 5, (bfraw*)smem, acc);
#pragma unroll
    for (int mi = 0; mi < 4; ++mi) {
      const float sc = sR[mi * 32 + r];
#pragma unroll
      for (int reg = 0; reg < 16; ++reg) acc[mi][reg] *= sc;
    }
    stage_tile<true>(sT, acc);
    __syncthreads();
#pragma unroll 2
    for (int i = 0; i < 8; ++i) {
      const int chunk = tid + 256 * i;
      const int row = chunk >> 4, cc = (chunk & 15) * 8;
      const int head = nt * 2 + (cc >> 6), d = cc & 63;
      *(uint4*)(p.KN + (((size_t)b * 8 + head) * LKEYS + kpos0 + row) * 64 + d) = *(const uint4*)(sT + row * ELD + cc);
    }
  } else {
    gemm128<false, 128>(A, INC, W, n0 >> 5, (bfraw*)smem, acc);
#pragma unroll
    for (int mi = 0; mi < 4; ++mi)
#pragma unroll
      for (int reg = 0; reg < 16; ++reg) acc[mi][reg] *= sR[mi * 32 + (reg & 3) + 8 * (reg >> 2) + 4 * h];
    stage_tile<false>(sT, acc);
    __syncthreads();
#pragma unroll 2
    for (int i = 0; i < 8; ++i) {
      const int chunk = tid + 256 * i;
      const int crow = chunk >> 4, cc = (chunk & 15) * 8;
      const int head = (nt - 4) * 2 + (crow >> 6), d = crow & 63;
      *(uint4*)(p.VT + (((size_t)b * 8 + head) * 64 + d) * LKEYS + kpos0 + cc) = *(const uint4*)(sT + crow * ELD + cc);
    }
  }
}

__device__ __forceinline__ int chunk_row0(int b, int c) { return c < 2 ? NLAT + b * CTX + c * 128 : b * SEQ + (c - 2) * 128; }
__device__ __forceinline__ float log2_sigmoid(float x) { return -log1pf(expf(-x)) * 1.4426950408889634f; }

#define TLD 136
__device__ void task_chunkstate(const Params& p, int layer, int b, int hd, int c, unsigned char* smem) {
  const int tid = otid(), lane = tid & 63, wave = tid >> 6, r = lane & 31, h = lane >> 5;
  bfraw* sKf = (bfraw*)smem;
  bfraw* sKb = sKf + 64 * TLD;
  bfraw* sV = sKb + 64 * TLD;
  const int R0 = chunk_row0(b, c);
  const float lgf = log2_sigmoid(p.dec_f[layer * 4 + hd]);
  const float lgb = log2_sigmoid(p.dec_b[layer * 4 + hd]);
  __syncthreads();
  {
    const int tok = tid >> 1, d0 = (tid & 1) * 32;
    const bfraw* kp = p.P + (size_t)(R0 + tok) * INC + C_RK + hd * 64 + d0;
    const bfraw* vp = p.P + (size_t)(R0 + tok) * INC + C_RV + hd * 64 + d0;
    const float wf = exp2f(lgf * (float)(127 - tok));
    const float wb = exp2f(lgb * (float)tok);
#pragma unroll
    for (int i = 0; i < 4; ++i) {
      uint4 ku = *(const uint4*)(kp + i * 8);
      uint4 vu = *(const uint4*)(vp + i * 8);
      unsigned kw[4] = {ku.x, ku.y, ku.z, ku.w};
      unsigned vw[4] = {vu.x, vu.y, vu.z, vu.w};
#pragma unroll
      for (int j = 0; j < 4; ++j) {
        const int d = d0 + i * 8 + j * 2;
        float k0 = lo_bf(kw[j]), k1 = hi_bf(kw[j]);
        sKf[d * TLD + tok] = f2bf(k0 * wf);
        sKf[(d + 1) * TLD + tok] = f2bf(k1 * wf);
        sKb[d * TLD + tok] = f2bf(k0 * wb);
        sKb[(d + 1) * TLD + tok] = f2bf(k1 * wb);
        sV[d * TLD + tok] = (bfraw)(vw[j] & 0xffffu);
        sV[(d + 1) * TLD + tok] = (bfraw)(vw[j] >> 16);
      }
    }
  }
  __syncthreads();
  const int dir = wave >> 1, mi = wave & 1;
  const bfraw* sK = dir ? sKb : sKf;
  f32x16 acc0 = zero16(), acc1 = zero16();
#pragma unroll
  for (int ks = 0; ks < 8; ++ks) {
    Frag a, b0, b1;
    a.u = *(const uint4*)(sK + (mi * 32 + r) * TLD + ks * 16 + h * 8);
    b0.u = *(const uint4*)(sV + (r)*TLD + ks * 16 + h * 8);
    b1.u = *(const uint4*)(sV + (32 + r) * TLD + ks * 16 + h * 8);
    acc0 = mfma32(a, b0, acc0);
    acc1 = mfma32(a, b1, acc1);
  }
  float* dst = p.CST + ((((size_t)b * 4 + hd) * NCHUNK + c) * 2 + dir) * 4096;
#pragma unroll
  for (int reg = 0; reg < 16; ++reg) {
    const int dk = mi * 32 + (reg & 3) + 8 * (reg >> 2) + 4 * h;
    dst[dk * 64 + r] = acc0[reg];
    dst[dk * 64 + 32 + r] = acc1[reg];
  }
}

#define CT 32
#define ALD 264
__device__ void task_conv(const Params& p, int layer, int seqrow0, int L, int t0, unsigned char* smem) {
  const int tid = otid(), lane = tid & 63, wave = tid >> 6, r = lane & 31, h = lane >> 5;
  bfraw* sU = (bfraw*)smem;
  float* sC = (float*)(smem + 31744);
  bfraw* sA = (bfraw*)smem;
  __syncthreads();
  for (int i = tid; i < 62 * 32; i += 256) {
    const int rr = i >> 5, cc = (i & 31) * 8;
    const int tok = t0 - 15 + rr;
    uint4 o = make_uint4(0, 0, 0, 0);
    if (tok >= 0 && tok < L) {
      const bfraw* src = p.P + (size_t)(seqrow0 + tok) * INC + C_GLU + cc;
      uint4 a = *(const uint4*)(src);
      uint4 g = *(const uint4*)(src + 256);
      o.x = pack2(lo_bf(a.x) * sigmf(lo_bf(g.x)), hi_bf(a.x) * sigmf(hi_bf(g.x)));
      o.y = pack2(lo_bf(a.y) * sigmf(lo_bf(g.y)), hi_bf(a.y) * sigmf(hi_bf(g.y)));
      o.z = pack2(lo_bf(a.z) * sigmf(lo_bf(g.z)), hi_bf(a.z) * sigmf(hi_bf(g.z)));
      o.w = pack2(lo_bf(a.w) * sigmf(lo_bf(g.w)), hi_bf(a.w) * sigmf(hi_bf(g.w)));
    }
    *(uint4*)(sU + rr * 256 + cc) = o;
  }
  __syncthreads();
  {
    const int ch = tid;
    float w[31];
#pragma unroll
    for (int j = 0; j < 31; ++j) w[j] = p.dw[((size_t)layer * 31 + j) * 256 + ch];
    const float bias = p.dw_b[layer * 256 + ch];
    for (int t = 0; t < CT; ++t) {
      float a = bias;
#pragma unroll
      for (int j = 0; j < 31; ++j) a += w[j] * bf2f(sU[(t + j) * 256 + ch]);
      sC[t * 256 + ch] = a;
    }
  }
  __syncthreads();
  {
    const float4 g4 = *(const float4*)(p.cln_g + layer * 256 + lane * 4);
    const float4 b4 = *(const float4*)(p.cln_b + layer * 256 + lane * 4);
#pragma unroll
    for (int i = 0; i < 8; ++i) {
      const int t = wave * 8 + i;
      float4 v = *(const float4*)(sC + t * 256 + lane * 4);
      float mu = wave_sum(v.x + v.y + v.z + v.w) * (1.f / 256.f);
      float dx = v.x - mu, dy = v.y - mu, dz = v.z - mu, dw_ = v.w - mu;
      float rstd = rsqrtf(wave_sum(dx * dx + dy * dy + dz * dz + dw_ * dw_) * (1.f / 256.f) + EPSF);
      float y0 = siluf(dx * rstd * g4.x + b4.x), y1 = siluf(dy * rstd * g4.y + b4.y);
      float y2 = siluf(dz * rstd * g4.z + b4.z), y3 = siluf(dw_ * rstd * g4.w + b4.w);
      *(uint2*)(sA + t * ALD + lane * 4) = make_uint2(pack2(y0, y1), pack2(y2, y3));
    }
  }
  __syncthreads();
  {
    const bfraw* W = p.wt_pw + (size_t)layer * 256 * 256;
    f32x16 acc0 = zero16(), acc1 = zero16();
#pragma unroll 4
    for (int ks = 0; ks < 16; ++ks) {
      Frag a, b0, b1;
      a.u = *(const uint4*)(sA + r * ALD + ks * 16 + h * 8);
      b0.u = *(const uint4*)(W + ((size_t)((wave * 2 + 0) * 16 + ks) * 64 + lane) * 8);
      b1.u = *(const uint4*)(W + ((size_t)((wave * 2 + 1) * 16 + ks) * 64 + lane) * 8);
      acc0 = mfma32(b0, a, acc0);
      acc1 = mfma32(b1, a, acc1);
    }
    const size_t row = (size_t)seqrow0 + t0 + r;
    const bfraw* gp = p.P + row * INC + C_GCONV + wave * 64;
    bfraw* op = p.U + row * DM + 768 + wave * 64;
    const float* pbp = p.pw_b + layer * 256 + wave * 64;
#pragma unroll
    for (int g = 0; g < 4; ++g) {
      const int n = 8 * g + 4 * h;
      uint2 gu = *(const uint2*)(gp + n);
      float4 b4 = *(const float4*)(pbp + n);
      float x0 = (acc0[g * 4 + 0] + b4.x) * siluf(lo_bf(gu.x));
      float x1 = (acc0[g * 4 + 1] + b4.y) * siluf(hi_bf(gu.x));
      float x2 = (acc0[g * 4 + 2] + b4.z) * siluf(lo_bf(gu.y));
      float x3 = (acc0[g * 4 + 3] + b4.w) * siluf(hi_bf(gu.y));
      *(uint2*)(op + n) = make_uint2(pack2(x0, x1), pack2(x2, x3));
      gu = *(const uint2*)(gp + 32 + n);
      b4 = *(const float4*)(pbp + 32 + n);
      x0 = (acc1[g * 4 + 0] + b4.x) * siluf(lo_bf(gu.x));
      x1 = (acc1[g * 4 + 1] + b4.y) * siluf(hi_bf(gu.x));
      x2 = (acc1[g * 4 + 2] + b4.z) * siluf(lo_bf(gu.y));
      x3 = (acc1[g * 4 + 3] + b4.w) * siluf(hi_bf(gu.y));
      *(uint2*)(op + 32 + n) = make_uint2(pack2(x0, x1), pack2(x2, x3));
    }
  }
}

#ifdef ONLYT
#define ENT(n) ((n) == ONLYT)
#else
#define ENT(n) true
#endif
__device__ void phase2(const Params& p, int layer, unsigned char* smem) {
  const bool need_ctx = (layer == 0);
  const int n_q = (need_ctx ? NROW / 128 : NLAT / 128) * 6;
  const int n_kv = (NROW / 128) * 8;
  const int n_cs = NB * 4 * NCHUNK;
  const int n_cv = NB * 64 + (need_ctx ? NB * 8 : 0);
  const int total = n_q + n_kv + n_cs + n_cv;
  for (int t = blockIdx.x; t < total; t += gridDim.x) {
    int tt = t;
    if (tt < n_cv) {
      int seqrow0, L, t0;
      if (tt < NB * 64) {
        seqrow0 = (tt >> 6) * SEQ; L = SEQ; t0 = (tt & 63) * CT;
      } else {
        tt -= NB * 64;
        seqrow0 = NLAT + (tt >> 3) * CTX; L = CTX; t0 = (tt & 7) * CT;
      }
      if (ENT(3)) task_conv(p, layer, seqrow0, L, t0, smem);
    } else if ((tt -= n_cv) < n_kv) {
      tt = xcd_remap(tt, n_kv);
      if (ENT(0)) task_kvup(p, layer, tt / 8, tt % 8, smem);
    } else if ((tt -= n_kv) < n_q) {
      tt = xcd_remap(tt, n_q);
      if (ENT(1)) task_qup(p, layer, tt / 6, tt % 6, smem);
    } else {
      tt -= n_q;
      const int c = tt % NCHUNK;
      const int bh = tt / NCHUNK;
      if (ENT(2)) task_chunkstate(p, layer, bh >> 2, bh & 3, c, smem);
    }
  }
}

#define KLD 104
#define VLD 72
__device__ __forceinline__ float fexp2(float x) { return __builtin_amdgcn_exp2f(x); }
__device__ __forceinline__ float xhalf_max(float x) {
  auto t = __builtin_amdgcn_permlane32_swap(__float_as_uint(x), __float_as_uint(x), false, false);
  return fmaxf(__uint_as_float(t[0]), __uint_as_float(t[1]));
}
__device__ __forceinline__ float xhalf_sum(float x) {
  auto t = __builtin_amdgcn_permlane32_swap(__float_as_uint(x), __float_as_uint(x), false, false);
  return __uint_as_float(t[0]) + __uint_as_float(t[1]);
}

__device__ void task_attn(const Params& p, int b, int hd, int qpos0, int nkeys, unsigned char* smem) {
  const int tid = otid(), lane = tid & 63, wave = tid >> 6, r = lane & 31, h = lane >> 5;
  bfraw* sK = (bfraw*)smem;
  bfraw* sV = sK + 2 * 64 * KLD;
  const size_t bh = (size_t)b * 8 + hd;
  const bfraw* KNp = p.KN + bh * LKEYS * 64;
  const bfraw* VTp = p.VT + bh * 64 * LKEYS;
  const int qpos = qpos0 + wave * 32 + r;
  Frag qf0, qf1, qf2, qf3, qf4, qf5;
  {
    const bfraw* qp = p.Q + (bh * LKEYS + qpos) * 96 + h * 8;
    qf0.u = *(const uint4*)(qp);
    qf1.u = *(const uint4*)(qp + 16);
    qf2.u = *(const uint4*)(qp + 32);
    qf3.u = *(const uint4*)(qp + 48);
    qf4.u = *(const uint4*)(qp + 64);
    qf5.u = *(const uint4*)(qp + 80);
  }
  const int k0key = tid / 12, k0cc = tid % 12;
  const int k1key = (tid + 256) / 12, k1cc = (tid + 256) % 12;
  const int k2key = (tid + 512) / 12, k2cc = (tid + 512) % 12;
  const int vd = tid >> 3, vcc = tid & 7;
  uint4 pk0, pk1, pk2, pv0, pv1;
#define KSRC(key, cc, key0)                                                                     \
  ((cc) < 8 ? (KNp + (size_t)((key0) + (key)) * 64 + (cc) * 8)                                   \
            : (p.KR + ((size_t)b * LKEYS + (key0) + (key)) * 32 + ((cc) - 8) * 8))
#define GLOAD(S, key0)                                                    \
  do {                                                                    \
    S##k0 = *(const uint4*)KSRC(k0key, k0cc, key0);                       \
    S##k1 = *(const uint4*)KSRC(k1key, k1cc, key0);                       \
    S##k2 = *(const uint4*)KSRC(k2key, k2cc, key0);                       \
    S##v0 = *(const uint4*)(VTp + (size_t)vd * LKEYS + (key0) + vcc * 8);        \
    S##v1 = *(const uint4*)(VTp + (size_t)(vd + 32) * LKEYS + (key0) + vcc * 8); \
  } while (0)
#define SSTORE(S, buf)                                                       \
  do {                                                                       \
    *(uint4*)(sK + (buf) * 64 * KLD + k0key * KLD + k0cc * 8) = S##k0;       \
    *(uint4*)(sK + (buf) * 64 * KLD + k1key * KLD + k1cc * 8) = S##k1;       \
    *(uint4*)(sK + (buf) * 64 * KLD + k2key * KLD + k2cc * 8) = S##k2;       \
    *(uint4*)(sV + (buf) * 64 * VLD + vd * VLD + vcc * 8) = S##v0;           \
    *(uint4*)(sV + (buf) * 64 * VLD + (vd + 32) * VLD + vcc * 8) = S##v1;    \
  } while (0)
#define ATT_TILE(buf)                                                              \
  {                                                                                \
    const bfraw* cK = sK + (buf) * 64 * KLD + r * KLD + h * 8;                     \
    const bfraw* cV = sV + (buf) * 64 * VLD + r * VLD + h * 4;                     \
    Frag ka[6], kb[6], va[4], vb[4];                                               \
    _Pragma("unroll") for (int ks = 0; ks < 6; ++ks) {                             \
      ka[ks].u = *(const uint4*)(cK + ks * 16);                                    \
      kb[ks].u = *(const uint4*)(cK + 32 * KLD + ks * 16);                         \
    }                                                                              \
    __builtin_amdgcn_sched_barrier(0);                                             \
    f32x16 s0 = zero16(), s1 = zero16();                                           \
    s0 = mfma32(ka[0], qf0, s0); s1 = mfma32(kb[0], qf0, s1);                      \
    s0 = mfma32(ka[1], qf1, s0); s1 = mfma32(kb[1], qf1, s1);                      \
    s0 = mfma32(ka[2], qf2, s0); s1 = mfma32(kb[2], qf2, s1);                      \
    s0 = mfma32(ka[3], qf3, s0); s1 = mfma32(kb[3], qf3, s1);                      \
    s0 = mfma32(ka[4], qf4, s0); s1 = mfma32(kb[4], qf4, s1);                      \
    s0 = mfma32(ka[5], qf5, s0); s1 = mfma32(kb[5], qf5, s1);                      \
    float mx = fmaxf(s0[0], s1[0]);                                                \
    _Pragma("unroll") for (int i = 1; i < 16; ++i) mx = fmaxf(mx, fmaxf(s0[i], s1[i])); \
    mx = xhalf_max(mx);                                            \
    if (__builtin_amdgcn_ballot_w64(mx > m + 8.0f) != 0ull) {                      \
        \
      const float mn = fmaxf(m, mx);                                               \
      const float al = fexp2(m - mn);                                              \
      m = mn;                                                                      \
      lsum *= al;                                                                  \
      _Pragma("unroll") for (int i = 0; i < 16; ++i) {                             \
        o0[i] *= al;                                                               \
        o1[i] *= al;                                                               \
      }                                                                            \
    }                                                                              \
    float ps;                                                                      \
    {                                                                              \
      const f2v mm = {m, m};                                                       \
      f2v ps2 = {0.f, 0.f};                                                        \
      _Pragma("unroll") for (int i = 0; i < 16; i += 2) {                          \
        f2v d0 = {s0[i], s0[i + 1]};                                               \
        f2v d1 = {s1[i], s1[i + 1]};                                               \
        d0 -= mm;                                                                  \
        d1 -= mm;                                                                  \
        d0.x = fexp2(d0.x); d0.y = fexp2(d0.y);                                    \
        d1.x = fexp2(d1.x); d1.y = fexp2(d1.y);                                    \
        ps2 += d0;                                                                 \
        ps2 += d1;                                                                 \
        s0[i] = d0.x; s0[i + 1] = d0.y;                                            \
        s1[i] = d1.x; s1[i + 1] = d1.y;                                            \
      }                                                                            \
      ps = ps2.x + ps2.y;                                                          \
    }                                                                              \
    _Pragma("unroll") for (int s = 0; s < 4; ++s) {                                \
      va[s].d[0] = *(const uint2*)(cV + s * 16);                                   \
      va[s].d[1] = *(const uint2*)(cV + s * 16 + 8);                               \
      vb[s].d[0] = *(const uint2*)(cV + 32 * VLD + s * 16);                        \
      vb[s].d[1] = *(const uint2*)(cV + 32 * VLD + s * 16 + 8);                    \
    }                                                                              \
    lsum += ps;                                                                    \
    _Pragma("unroll") for (int s = 0; s < 2; ++s) {                                \
      Frag pb;                                                                     \
      pb.w[0] = pack2(s0[8 * s + 0], s0[8 * s + 1]);                               \
      pb.w[1] = pack2(s0[8 * s + 2], s0[8 * s + 3]);                               \
      pb.w[2] = pack2(s0[8 * s + 4], s0[8 * s + 5]);                               \
      pb.w[3] = pack2(s0[8 * s + 6], s0[8 * s + 7]);                               \
      o0 = mfma32(va[s], pb, o0);                                                  \
      o1 = mfma32(vb[s], pb, o1);                                                  \
    }                                                                              \
    _Pragma("unroll") for (int s = 0; s < 2; ++s) {                                \
      Frag pb;                                                                     \
      pb.w[0] = pack2(s1[8 * s + 0], s1[8 * s + 1]);                               \
      pb.w[1] = pack2(s1[8 * s + 2], s1[8 * s + 3]);                               \
      pb.w[2] = pack2(s1[8 * s + 4], s1[8 * s + 5]);                               \
      pb.w[3] = pack2(s1[8 * s + 6], s1[8 * s + 7]);                               \
      o0 = mfma32(va[2 + s], pb, o0);                                              \
      o1 = mfma32(vb[2 + s], pb, o1);                                              \
    }                                                                              \
  }
#define QK(ks, qf)
  f32x16 o0 = zero16(), o1 = zero16();
  float m = -1e30f, lsum = 0.f;
  const int nt = nkeys >> 6;
  __syncthreads();
  GLOAD(p, 0);
  SSTORE(p, 0);
  __syncthreads();
  for (int kt = 0; kt < nt; kt += 2) {
    GLOAD(p, (kt + 1) * 64);
    ATT_TILE(0)
    SSTORE(p, 1);
    __syncthreads();
    if (kt + 2 < nt) GLOAD(p, (kt + 2) * 64);
    ATT_TILE(1)
    if (kt + 2 < nt) SSTORE(p, 0);
    __syncthreads();
  }
#undef QK
#undef ATT_TILE
#undef GLOAD
#undef SSTORE
#undef KSRC
  lsum = xhalf_sum(lsum);
  const float inv = 1.0f / lsum;
  const int row = keyrow(b, qpos);
  const bfraw* gp = p.P + (size_t)row * INC + C_GMLA + hd * 64;
  bfraw* op = p.U + (size_t)row * DM + hd * 64;
#pragma unroll
  for (int g = 0; g < 4; ++g) {
    const int d = 8 * g + 4 * h;
    uint2 gu = *(const uint2*)(gp + d);
    float x0 = o0[g * 4 + 0] * inv * siluf(lo_bf(gu.x));
    float x1 = o0[g * 4 + 1] * inv * siluf(hi_bf(gu.x));
    float x2 = o0[g * 4 + 2] * inv * siluf(lo_bf(gu.y));
    float x3 = o0[g * 4 + 3] * inv * siluf(hi_bf(gu.y));
    *(uint2*)(op + d) = make_uint2(pack2(x0, x1), pack2(x2, x3));
    gu = *(const uint2*)(gp + 32 + d);
    x0 = o1[g * 4 + 0] * inv * siluf(lo_bf(gu.x));
    x1 = o1[g * 4 + 1] * inv * siluf(hi_bf(gu.x));
    x2 = o1[g * 4 + 2] * inv * siluf(lo_bf(gu.y));
    x3 = o1[g * 4 + 3] * inv * siluf(hi_bf(gu.y));
    *(uint2*)(op + 32 + d) = make_uint2(pack2(x0, x1), pack2(x2, x3));
  }
}

__device__ void task_prefix(const Params& p, int layer, int pt) {
  const int tid = otid();
  const int bh = pt >> 4, dir = (pt >> 3) & 1, slice = pt & 7;
  const int hd = bh & 3;
  const float lg = log2_sigmoid(dir ? p.dec_b[layer * 4 + hd] : p.dec_f[layer * 4 + hd]);
  const float cd = exp2f(lg * 128.f);
  const size_t eoff = ((size_t)bh * NCHUNK) * 2 * 4096 + (size_t)dir * 4096 + slice * 512 + 2 * tid;
  const float* base = p.CST + eoff;
  bfraw* obase = p.PRE + eoff;
  float2 v[1][NCHUNK];
#pragma unroll
  for (int s2 = 0; s2 < NCHUNK; ++s2) {
    const int c2 = dir ? (s2 < 2 ? 1 - s2 : 19 - s2) : s2;
#pragma unroll
    for (int j = 0; j < 1; ++j) v[j][s2] = *(const float2*)(base + (size_t)c2 * 2 * 4096 + j * 512);
  }
  float2 S[1] = {make_float2(0.f, 0.f)};
#pragma unroll
  for (int s2 = 0; s2 < NCHUNK; ++s2) {
    const int c2 = dir ? (s2 < 2 ? 1 - s2 : 19 - s2) : s2;
#pragma unroll
    for (int j = 0; j < 1; ++j) {
      __hip_atomic_store((unsigned*)(obase + (size_t)c2 * 2 * 4096 + j * 512), pack2(S[j].x, S[j].y), __ATOMIC_RELAXED,
                         __HIP_MEMORY_SCOPE_AGENT);
      S[j].x = S[j].x * cd + v[j][s2].x;
      S[j].y = S[j].y * cd + v[j][s2].y;
    }
  }
  asm volatile("s_waitcnt vmcnt(0)" ::: "memory");
  __syncthreads();
  if (tid == 0) (void)xb_add(&p.bar[XCD_BAR_WORDS + layer * 32 + bh], 1u);
}

#define SLD 72
__device__ void task_retout(const Params& p, int layer, int b, int hd, int c, unsigned char* smem) {
  const int tid = otid(), lane = tid & 63, wave = tid >> 6, r = lane & 31, h = lane >> 5;
  bfraw* sV = (bfraw*)smem;
  bfraw* sSf = sV + 64 * TLD;
  bfraw* sSb = sSf + 64 * SLD;
  const int R0 = chunk_row0(b, c);
  const float lgf = log2_sigmoid(p.dec_f[layer * 4 + hd]);
  const float lgb = log2_sigmoid(p.dec_b[layer * 4 + hd]);
  const float cdf = exp2f(lgf * 128.f), cdb = exp2f(lgb * 128.f);
  __syncthreads();
  {
    const int tok = tid >> 1, d0 = (tid & 1) * 32;
    const bfraw* vp = p.P + (size_t)(R0 + tok) * INC + C_RV + hd * 64 + d0;
#pragma unroll
    for (int i = 0; i < 4; ++i) {
      uint4 vu = *(const uint4*)(vp + i * 8);
      unsigned vw[4] = {vu.x, vu.y, vu.z, vu.w};
#pragma unroll
      for (int j = 0; j < 4; ++j) {
        const int d = d0 + i * 8 + j * 2;
        sV[d * TLD + tok] = (bfraw)(vw[j] & 0xffffu);
        sV[(d + 1) * TLD + tok] = (bfraw)(vw[j] >> 16);
      }
    }
  }
  {
    unsigned* rdy = &p.bar[XCD_BAR_WORDS + layer * 32 + b * 4 + hd];
    if (tid == 0) {
      XB_SPIN(xb_ld(rdy) < 16u, p.bar);
    }
    __syncthreads();
    const bfraw* pf = p.PRE + ((((size_t)b * 4 + hd) * NCHUNK + c) * 2) * 4096;
#pragma unroll
    for (int j = 0; j < 2; ++j) {
      const int e0 = (tid + 256 * j) * 8;
      const int dk = e0 >> 6, dv0 = e0 & 63;
      const unsigned long long f0 = __hip_atomic_load((unsigned long long*)(pf + e0), __ATOMIC_RELAXED, __HIP_MEMORY_SCOPE_AGENT);
      const unsigned long long f1 = __hip_atomic_load((unsigned long long*)(pf + e0 + 4), __ATOMIC_RELAXED, __HIP_MEMORY_SCOPE_AGENT);
      const unsigned long long b0 = __hip_atomic_load((unsigned long long*)(pf + 4096 + e0), __ATOMIC_RELAXED, __HIP_MEMORY_SCOPE_AGENT);
      const unsigned long long b1 = __hip_atomic_load((unsigned long long*)(pf + 4096 + e0 + 4), __ATOMIC_RELAXED, __HIP_MEMORY_SCOPE_AGENT);
      unsigned wf[4] = {(unsigned)f0, (unsigned)(f0 >> 32), (unsigned)f1, (unsigned)(f1 >> 32)};
      unsigned wb[4] = {(unsigned)b0, (unsigned)(b0 >> 32), (unsigned)b1, (unsigned)(b1 >> 32)};
#pragma unroll
      for (int q = 0; q < 4; ++q) {
        sSf[(dv0 + 2 * q) * SLD + dk] = (bfraw)(wf[q] & 0xffffu);
        sSf[(dv0 + 2 * q + 1) * SLD + dk] = (bfraw)(wf[q] >> 16);
        sSb[(dv0 + 2 * q) * SLD + dk] = (bfraw)(wb[q] & 0xffffu);
        sSb[(dv0 + 2 * q + 1) * SLD + dk] = (bfraw)(wb[q] >> 16);
      }
    }
  }
  const int qi = wave * 32 + r;
  Frag qf[4];
  {
    const bfraw* qp = p.P + (size_t)(R0 + qi) * INC + C_RQ + hd * 64 + h * 8;
#pragma unroll
    for (int ks = 0; ks < 4; ++ks) qf[ks].u = *(const uint4*)(qp + ks * 16);
  }
  __syncthreads();
  f32x16 o0, o1;
  {
    f32x16 x0 = zero16(), x1 = zero16();
#pragma unroll
    for (int ks = 0; ks < 4; ++ks) {
      Frag a0, a1;
      a0.u = *(const uint4*)(sSf + r * SLD + ks * 16 + h * 8);
      a1.u = *(const uint4*)(sSf + (32 + r) * SLD + ks * 16 + h * 8);
      x0 = mfma32(a0, qf[ks], x0);
      x1 = mfma32(a1, qf[ks], x1);
    }
    const float sf = exp2f(lgf * (float)(qi + 1));
#pragma unroll
    for (int i = 0; i < 16; ++i) {
      o0[i] = x0[i] * sf;
      o1[i] = x1[i] * sf;
    }
    x0 = zero16();
    x1 = zero16();
#pragma unroll
    for (int ks = 0; ks < 4; ++ks) {
      Frag a0, a1;
      a0.u = *(const uint4*)(sSb + r * SLD + ks * 16 + h * 8);
      a1.u = *(const uint4*)(sSb + (32 + r) * SLD + ks * 16 + h * 8);
      x0 = mfma32(a0, qf[ks], x0);
      x1 = mfma32(a1, qf[ks], x1);
    }
    const float sb = exp2f(lgb * (float)(128 - qi));
#pragma unroll
    for (int i = 0; i < 16; ++i) {
      o0[i] += x0[i] * sb;
      o1[i] += x1[i] * sb;
    }
  }
#pragma unroll 1
  for (int kt = 0; kt < 4; ++kt) {
    f32x16 s = zero16();
    const bfraw* kp = p.P + (size_t)(R0 + kt * 32 + r) * INC + C_RK + hd * 64 + h * 8;
#pragma unroll
    for (int ks = 0; ks < 4; ++ks) {
      Frag a;
      a.u = *(const uint4*)(kp + ks * 16);
      s = mfma32(a, qf[ks], s);
    }
#pragma unroll
    for (int reg = 0; reg < 16; ++reg) {
      const int j = kt * 32 + (reg & 3) + 8 * (reg >> 2) + 4 * h;
      const int d = qi - j;
      const float w = fexp2(d >= 0 ? lgf * (float)d : lgb * (float)(-d));
      s[reg] *= w;
    }
#pragma unroll
    for (int s2 = 0; s2 < 2; ++s2) {
      Frag pb, v0, v1;
      pb.w[0] = pack2(s[8 * s2 + 0], s[8 * s2 + 1]);
      pb.w[1] = pack2(s[8 * s2 + 2], s[8 * s2 + 3]);
      pb.w[2] = pack2(s[8 * s2 + 4], s[8 * s2 + 5]);
      pb.w[3] = pack2(s[8 * s2 + 6], s[8 * s2 + 7]);
      const int ko = kt * 32 + s2 * 16 + h * 4;
      v0.d[0] = *(const uint2*)(sV + r * TLD + ko);
      v0.d[1] = *(const uint2*)(sV + r * TLD + ko + 8);
      v1.d[0] = *(const uint2*)(sV + (32 + r) * TLD + ko);
      v1.d[1] = *(const uint2*)(sV + (32 + r) * TLD + ko + 8);
      o0 = mfma32(v0, pb, o0);
      o1 = mfma32(v1, pb, o1);
    }
  }
  float sm_ = 0.f;
#pragma unroll
  for (int i = 0; i < 16; ++i) sm_ += o0[i] + o1[i];
  sm_ = xhalf_sum(sm_);
  const float mu = sm_ * (1.f / 64.f);
  float q = 0.f;
#pragma unroll
  for (int i = 0; i < 16; ++i) {
    float d0 = o0[i] - mu, d1 = o1[i] - mu;
    q += d0 * d0 + d1 * d1;
  }
  q = xhalf_sum(q);
  const float rstd = rsqrtf(q * (1.f / 64.f) + EPSF);
  const size_t row = (size_t)R0 + qi;
  const bfraw* gp = p.P + row * INC + C_GRET + hd * 64;
  bfraw* op = p.U + row * DM + 512 + hd * 64;
  const float* gg = p.gn_g + layer * 256 + hd * 64;
  const float* gb = p.gn_b + layer * 256 + hd * 64;
#pragma unroll
  for (int dt = 0; dt < 2; ++dt) {
#pragma unroll
    for (int g = 0; g < 4; ++g) {
      const int d = dt * 32 + 8 * g + 4 * h;
      uint2 gu = *(const uint2*)(gp + d);
      float4 g4 = *(const float4*)(gg + d);
      float4 b4 = *(const float4*)(gb + d);
      float x0 = ((dt ? o1[g * 4 + 0] : o0[g * 4 + 0]) - mu) * rstd * g4.x + b4.x;
      float x1 = ((dt ? o1[g * 4 + 1] : o0[g * 4 + 1]) - mu) * rstd * g4.y + b4.y;
      float x2 = ((dt ? o1[g * 4 + 2] : o0[g * 4 + 2]) - mu) * rstd * g4.z + b4.z;
      float x3 = ((dt ? o1[g * 4 + 3] : o0[g * 4 + 3]) - mu) * rstd * g4.w + b4.w;
      x0 *= siluf(lo_bf(gu.x));
      x1 *= siluf(hi_bf(gu.x));
      x2 *= siluf(lo_bf(gu.y));
      x3 *= siluf(hi_bf(gu.y));
      *(uint2*)(op + d) = make_uint2(pack2(x0, x1), pack2(x2, x3));
    }
  }
}

__device__ void phase3(const Params& p, int layer, unsigned char* smem) {
  const bool need_ctx = (layer == 0);
  const int n_pf = 512;
  const int n_at = NB * 8 * 16 + (need_ctx ? NB * 8 * 2 : 0);
  const int n_rt = NB * 4 * (need_ctx ? 18 : 16);
  const int total = n_pf + n_at + n_rt;
  for (int t0_ = blockIdx.x; t0_ < total; t0_ += gridDim.x) {
    if (t0_ < n_pf) {
      task_prefix(p, layer, t0_);
      continue;
    }
    const int t1_ = t0_ - n_pf;
    const int t = t1_ < NB * 8 * 16 ? xcd_remap(t1_, NB * 8 * 16) : t1_;
    if (t < NB * 8 * 16) {
      const int qb = t & 15, bh = t >> 4;
      task_attn(p, bh >> 3, bh & 7, CTX + qb * 128, LKEYS, smem);
    } else if (t < n_at) {
      const int tt = t - NB * 8 * 16;
      const int qb = tt & 1, bh = tt >> 1;
      task_attn(p, bh >> 3, bh & 7, qb * 128, CTX, smem);
    } else {
      const int tt = t - n_at;
      const int nc = need_ctx ? 18 : 16;
      const int c = tt % nc + (need_ctx ? 0 : 2);
      const int bh = tt / nc;
      task_retout(p, layer, bh >> 2, bh & 3, c, smem);
    }
  }
}

__device__ void phase4(const Params& p, int layer, unsigned char* smem) {
  const int tid = otid();
  const int MT = (layer == 0 ? NROW : NLAT) / 128, NT = 8;
  const bfraw* W = p.wt_out + (size_t)layer * 1024 * 1024;
  bfraw* Y = p.P;
  bfraw* sT = (bfraw*)smem;
  for (int t0_ = blockIdx.x; t0_ < MT * NT; t0_ += gridDim.x) {
    const int t = xcd_remap(t0_, MT * NT);
    int mt, nt;
    grouped_tile(t, MT, NT, mt, nt);
    const int m0 = mt * 128, n0 = nt * 128;
    f32x16 acc[4];
    gemm128<true, 1024>(p.U + (size_t)m0 * DM, DM, W, n0 >> 5, (bfraw*)smem, acc);
    stage_tile<true>(sT, acc);
    __syncthreads();
#pragma unroll 2
    for (int i = 0; i < 8; ++i) {
      const int chunk = tid + 256 * i;
      const int row = chunk >> 4, cc = (chunk & 15) * 8;
      *(uint4*)(Y + (size_t)(m0 + row) * DM + n0 + cc) = *(const uint4*)(sT + row * ELD + cc);
    }
    __syncthreads();
  }
}


#ifdef ONLY
#define EN(n) ((n) == ONLY)
#else
#define EN(n) true
#endif
__global__ void __launch_bounds__(256, 2) mega(Params p) {
  extern __shared__ __attribute__((aligned(16))) unsigned char smem_dyn[];
  unsigned char* smem = smem_dyn + 16;
  uint4& xb_words = *(uint4*)smem_dyn;
  cg::grid_group grid = cg::this_grid();
  if (threadIdx.x == 0) xb_words = make_uint4(0u, 0u, 0u, 0u);
  __syncthreads();
  XcdBarrier xb = xcd_barrier_post(p.bar, (volatile LAS unsigned*)&xb_words);
  if (p.phase_begin < 0) grid.sync();
  for (int ph = p.phase_begin; ph < p.phase_end; ++ph) {
    if (ph > p.phase_begin) xcd_barrier(xb);
    if (ph == 0) { if (EN(0)) phase0a(p, smem, 0); }
    else if (ph == 1) { if (EN(1)) { phase0a(p, smem, 1); phase_rows(p, 0, true); } }
    else {
      const int layer = (ph - 2) / 5, sub = (ph - 2) % 5;
      if (sub == 0) { if (EN(2)) phase1(p, layer, smem); }
      else if (sub == 1) { if (EN(3)) phase2(p, layer, smem); }
      else if (sub == 2) { if (EN(4)) phase3(p, layer, smem); }
      else if (sub == 3) { if (EN(5)) phase4(p, layer, smem); }
      else { if (EN(6)) phase_rows(p, layer, false); }
    }
  }
}

extern "C" void kernel_launch(void* const* d_in, const int* in_sizes, int n_in, void* d_out, int out_size, void* d_ws,
                              size_t ws_size, hipStream_t stream) {
  static int grid_blocks = 0;
  if (!grid_blocks) {
    int dev = 0, cus = 0, per_cu = 0;
    hipGetDevice(&dev);
    hipDeviceGetAttribute(&cus, hipDeviceAttributeMultiprocessorCount, dev);
    hipFuncSetAttribute((const void*)mega, hipFuncAttributeMaxDynamicSharedMemorySize, DYN_LDS);
    hipOccupancyMaxActiveBlocksPerMultiprocessor(&per_cu, mega, 256, DYN_LDS);
    if (per_cu > 2) per_cu = 2;
    if (per_cu < 1) per_cu = 1;
    grid_blocks = cus * per_cu;
  }
  Params p{};
  const float* const* in = (const float* const*)d_in;
  p.x = in[0]; p.c = in[1]; p.ctx = in[2]; p.c_ctx = in[3]; p.w_mod = in[4]; p.b_mod = in[5]; p.w_in = in[6];
  p.g_q = in[7]; p.w_uq = in[8]; p.g_kv = in[9]; p.w_ukv = in[10]; p.dec_f = in[11]; p.dec_b = in[12];
  p.gn_g = in[13]; p.gn_b = in[14]; p.dw = in[15]; p.dw_b = in[16]; p.cln_g = in[17]; p.cln_b = in[18];
  p.pw = in[19]; p.pw_b = in[20]; p.w_out = in[21]; p.ln_g = in[22]; p.ln_b = in[23];
  p.out = (float*)d_out;
  size_t off = 0;
  auto take = [&](size_t bytes) {
    void* q = (char*)d_ws + off;
    off += (bytes + 255) & ~(size_t)255;
    return q;
  };
  p.wt_in = (bfraw*)take((size_t)2 * INCP * 1024 * 2);
  p.wt_uq = (bfraw*)take((size_t)2 * 768 * 256 * 2);
  p.wt_ukv = (bfraw*)take((size_t)2 * 1024 * 128 * 2);
  p.wt_pw = (bfraw*)take((size_t)2 * 256 * 256 * 2);
  p.wt_out = (bfraw*)take((size_t)2 * 1024 * 1024 * 2);
  p.mod = (float*)take((size_t)2 * 9 * 3072 * 4);
  p.tabA = (float2*)take(64 * 8 * 8);
  p.tabB = (float2*)take(64 * 16 * 8);
  p.U = (bfraw*)take((size_t)NROW * DM * 2);
  p.P = (bfraw*)take((size_t)NROW * INC * 2);
  p.Q = (bfraw*)take((size_t)NB * 8 * LKEYS * 96 * 2);
  p.KN = (bfraw*)take((size_t)NB * 8 * LKEYS * 64 * 2);
  p.VT = (bfraw*)take((size_t)NB * 8 * 64 * LKEYS * 2);
  p.CST = (float*)take((size_t)NB * 4 * NCHUNK * 2 * 4096 * 4);
  p.HC1 = (float*)take((size_t)NCTX * DM * 4);
  p.bar = (unsigned*)take((size_t)(XCD_BAR_WORDS + 64) * 4);
  p.KR = (bfraw*)take((size_t)NB * LKEYS * 32 * 2);
  p.PRE = (bfraw*)take((size_t)NB * 4 * NCHUNK * 2 * 4096 * 2);
  if (off > ws_size) {
    fprintf(stderr, "workspace too small: need %zu have %zu\n", off, ws_size);
    return;
  }
  hipMemsetAsync(p.bar, 0, (size_t)(XCD_BAR_WORDS + 64) * 4, stream);
#if ONE_LAUNCH
  p.phase_begin = 0;
  p.phase_end = NPHASE;
  void* args[] = {&p};
  hipError_t e = hipLaunchCooperativeKernel((void*)mega, dim3(grid_blocks), dim3(256), args, DYN_LDS, stream);
  if (e != hipSuccess) fprintf(stderr, "cooperative launch failed: %s (grid %d)\n", hipGetErrorString(e), grid_blocks);
#else
  for (int ph = 0; ph < NPHASE; ++ph) {
    p.phase_begin = ph;
    p.phase_end = ph + 1;
    hipLaunchKernelGGL(mega, dim3(grid_blocks), dim3(256), DYN_LDS, stream, p);
  }
#endif
}
```

```cpp
#include <hip/hip_runtime.h>
#include <hip/hip_cooperative_groups.h>
#include <cstdio>
#include <cstdint>
namespace cg = cooperative_groups;

#ifndef ONE_LAUNCH
#define ONE_LAUNCH 1
#endif

typedef unsigned short bfraw;
typedef __attribute__((ext_vector_type(8))) __bf16 bf16x8;
typedef __attribute__((ext_vector_type(16))) float f32x16;

#define DM 1024
#define NB 8
#define SEQ 2048
#define CTX 256
#define NLAT (NB * SEQ)
#define NCTX (NB * CTX)
#define NROW (NLAT + NCTX)
#define INC 2720
#define INCP 2816
#define LKEYS 2304
#define C_PQ 0
#define C_PKV 256
#define C_PKR 384
#define C_GMLA 416
#define C_RQ 928
#define C_RK 1184
#define C_RV 1440
#define C_GRET 1696
#define C_GLU 1952
#define C_GCONV 2464
#define NCHUNK 18
#define EPSF 1e-5f
#define ALPHA_F 1.4142135623730951f
#define NPHASE 12
#define DYN_LDS (16 + 31744 + 32768)

struct Params {
  const float *x, *c, *ctx, *c_ctx, *w_mod, *b_mod, *w_in, *g_q, *w_uq, *g_kv, *w_ukv, *dec_f, *dec_b, *gn_g, *gn_b,
      *dw, *dw_b, *cln_g, *cln_b, *pw, *pw_b, *w_out, *ln_g, *ln_b;
  float* out;
  bfraw *wt_in, *wt_uq, *wt_ukv, *wt_pw, *wt_out;
  float* mod;
  float2* tabA;
  float2* tabB;
  bfraw* U;
  bfraw* P;
  bfraw *Q, *KN, *VT;
  float* CST;
  float* HC1;
  unsigned* bar;
  bfraw* KR;
  bfraw* PRE;
  int phase_begin, phase_end;
};

typedef __attribute__((ext_vector_type(2))) float f2v;
typedef __attribute__((ext_vector_type(2))) __bf16 bf2v;
__device__ __forceinline__ unsigned pack2(float a, float b) {
  f2v v = {a, b};
  bf2v r = __builtin_convertvector(v, bf2v);
  return __builtin_bit_cast(unsigned, r);
}
__device__ __forceinline__ bfraw f2bf(float f) { return (bfraw)(pack2(f, 0.f) & 0xffffu); }
__device__ __forceinline__ float bf2f(bfraw b) { return __uint_as_float(((unsigned)b) << 16); }
__device__ __forceinline__ float lo_bf(unsigned u) { return __uint_as_float(u << 16); }
__device__ __forceinline__ float hi_bf(unsigned u) { return __uint_as_float(u & 0xffff0000u); }
__device__ __forceinline__ float siluf(float x) { return x * __builtin_amdgcn_rcpf(1.0f + __expf(-x)); }
__device__ __forceinline__ float sigmf(float x) { return __builtin_amdgcn_rcpf(1.0f + __expf(-x)); }

__device__ __forceinline__ int otid() {
  int t = threadIdx.x;
  asm volatile("" : "+v"(t));
  return t;
}

union Frag {
  bf16x8 v;
  uint4 u;
  uint2 d[2];
  unsigned w[4];
};

__device__ __forceinline__ f32x16 mfma32(const Frag& a, const Frag& b, f32x16 c) {
  return __builtin_amdgcn_mfma_f32_32x32x16_bf16(a.v, b.v, c, 0, 0, 0);
}
__device__ __forceinline__ f32x16 zero16() {
  f32x16 z;
#pragma unroll
  for (int i = 0; i < 16; ++i) z[i] = 0.f;
  return z;
}
__device__ __forceinline__ float wave_sum(float v) {
#pragma unroll
  for (int o = 32; o > 0; o >>= 1) v += __shfl_xor(v, o);
  return v;
}

#define XB_TMO      128
#define XB_XCNT(j)  (256  + 64 * (j))
#define XB_XSUB(j)  (1280 + 64 * (j))
#define XB_XGEN(j)  (2304 + 64 * (j))
#define XB_TOP      3328
#define XB_TOPGEN   3392
#define XCD_BAR_WORDS 3456
#define XB_SPIN_CAP (1u << 22)
#define LAS __attribute__((address_space(3)))
__device__ __forceinline__ unsigned xb_ld(unsigned* p) { return __hip_atomic_load(p, __ATOMIC_RELAXED, __HIP_MEMORY_SCOPE_AGENT); }
__device__ __forceinline__ unsigned xb_add(unsigned* p, unsigned v) { return __hip_atomic_fetch_add(p, v, __ATOMIC_RELAXED, __HIP_MEMORY_SCOPE_AGENT); }
__device__ __forceinline__ unsigned xb_xcc_id() { return (unsigned)__builtin_amdgcn_s_getreg((3 << 11) | 20) & 0xFu; }
#define XB_SPIN(cond, bar) do { unsigned _sp = 0; while (cond) { __builtin_amdgcn_s_sleep(1); \
    if ((++_sp & 255u) == 0u) { if (xb_ld(&(bar)[XB_TMO])) break; if (_sp > XB_SPIN_CAP) { atomicAdd(&(bar)[XB_TMO], 1u); break; } } } } while (0)
struct XcdBarrier {
  unsigned* bar;
  unsigned x;
  volatile LAS unsigned* st;
};
__device__ __forceinline__ XcdBarrier xcd_barrier_post(unsigned* bar, volatile LAS unsigned* st) {
  XcdBarrier b;
  b.bar = bar;
  b.x = xb_xcc_id();
  b.st = st;
  if (threadIdx.x == 0) (void)xb_add(&bar[XB_XCNT(b.x)], 1u);
  return b;
}
__device__ __forceinline__ void xcd_barrier_complete(unsigned* bar, unsigned x, unsigned& nloc, unsigned& nx) {
  const unsigned G = gridDim.x * gridDim.y * gridDim.z;
  unsigned sum, cnt, mine, sp = 0u;
  for (;;) {
    sum = 0u; cnt = 0u; mine = 0u;
#pragma unroll
    for (unsigned j = 0; j < 16; ++j) {
      const unsigned c = xb_ld(&bar[XB_XCNT(j)]);
      sum += c;
      cnt += (c > 0u) ? 1u : 0u;
      mine = (j == x) ? c : mine;
    }
    if (sum == G) break;
    __builtin_amdgcn_s_sleep(1);
    if ((++sp & 255u) == 0u) {
      if (xb_ld(&bar[XB_TMO])) break;
      if (sp > XB_SPIN_CAP) { atomicAdd(&bar[XB_TMO], 1u); break; }
    }
  }
  nloc = mine > 0u ? mine : 1u;
  nx = cnt > 0u ? cnt : 1u;
}
__device__ __forceinline__ void xcd_barrier(const XcdBarrier& b) {
  asm volatile("s_waitcnt vmcnt(0)" ::: "memory");
  __syncthreads();
  if (threadIdx.x == 0) {
    unsigned* bar = b.bar;
    __builtin_amdgcn_s_waitcnt(0);
    unsigned nloc = b.st[0], nx = b.st[1];
    if (nloc == 0u) { xcd_barrier_complete(bar, b.x, nloc, nx); b.st[0] = nloc; b.st[1] = nx; }
    const unsigned old = xb_add(&bar[XB_XSUB(b.x)], 1u);
    const unsigned gen = old / nloc;
    if (old + 1u == (gen + 1u) * nloc) {
      __builtin_amdgcn_fence(__ATOMIC_RELEASE, "agent");
      asm volatile("s_waitcnt vmcnt(0)" ::: "memory");
      const unsigned og = xb_add(&bar[XB_TOP], 1u);
      const unsigned tg = og / nx;
      if (og + 1u == (tg + 1u) * nx) xb_add(&bar[XB_TOPGEN], 1u);
      else XB_SPIN(xb_ld(&bar[XB_TOPGEN]) == tg, bar);
      __builtin_amdgcn_fence(__ATOMIC_ACQUIRE, "agent");
      xb_add(&bar[XB_XGEN(b.x)], 1u);
      asm volatile("s_waitcnt vmcnt(0)" ::: "memory");
    } else {
      XB_SPIN(xb_ld(&bar[XB_XGEN(b.x)]) == gen, bar);
      __builtin_amdgcn_fence(__ATOMIC_ACQUIRE, "agent");
      asm volatile("s_waitcnt vmcnt(0)" ::: "memory");
    }
  }
  __syncthreads();
}


#define GLD 72
#define GEMM_LDS (2 * 128 * GLD * 2)
template <bool TRANS, int K>
__device__ __forceinline__ void gemm128(const bfraw* __restrict__ A, int lda, const bfraw* __restrict__ Bsw, int nt32_0,
                                        bfraw* sm, f32x16 (&acc)[4]) {
  const int tid = otid(), lane = tid & 63, wave = tid >> 6, r = lane & 31, h = lane >> 5;
  constexpr int KS = K >> 4;
  constexpr int nk = K >> 6;
  bfraw* sA = sm;
  const int lr = tid >> 3, lc = (tid & 7) * 8;
  const bfraw* ga = A + (size_t)lr * lda + lc;
  const bfraw* gb0 = Bsw + ((size_t)(nt32_0 + wave) * KS * 64 + lane) * 8;
  uint4 pa0, pa1, pa2, pa3, qa0, qa1, qa2, qa3;
  Frag bf[2][4];
#define GL(S)                                              \
  S##a0 = *(const uint4*)(ga);                             \
  S##a1 = *(const uint4*)(ga + (size_t)32 * lda);          \
  S##a2 = *(const uint4*)(ga + (size_t)64 * lda);          \
  S##a3 = *(const uint4*)(ga + (size_t)96 * lda);
#define SL(S, buf)                                                         \
  *(uint4*)(sA + (buf) * 128 * GLD + lr * GLD + lc) = S##a0;              \
  *(uint4*)(sA + (buf) * 128 * GLD + (lr + 32) * GLD + lc) = S##a1;       \
  *(uint4*)(sA + (buf) * 128 * GLD + (lr + 64) * GLD + lc) = S##a2;       \
  *(uint4*)(sA + (buf) * 128 * GLD + (lr + 96) * GLD + lc) = S##a3;
#define BL(set, kt_)                                                                       \
  _Pragma("unroll") for (int ks = 0; ks < 4; ++ks) {                                       \
    bf[set][ks].u = *(const uint4*)(gb0 + (size_t)((kt_) * 4 + ks) * 512);                 \
  }
#define COMPUTE(buf, set)                                                         \
  {                                                                               \
    const bfraw* cA = sA + (buf) * 128 * GLD + r * GLD + h * 8;                   \
    _Pragma("unroll") for (int ks = 0; ks < 4; ++ks) {                            \
      _Pragma("unroll") for (int mi = 0; mi < 4; ++mi) {                          \
        Frag a0;                                                                  \
        a0.u = *(const uint4*)(cA + mi * 32 * GLD + ks * 16);                     \
        if (TRANS) acc[mi] = mfma32(bf[set][ks], a0, acc[mi]);                    \
        else acc[mi] = mfma32(a0, bf[set][ks], acc[mi]);                          \
      }                                                                           \
    }                                                                             \
  }
  GL(p)
  BL(0, 0)
  ga += 64;
  GL(q)
#pragma unroll
  for (int i = 0; i < 4; ++i) acc[i] = zero16();
  SL(p, 0)
  __syncthreads();
#pragma unroll
  for (int kt = 0; kt < nk; kt += 2) {
    if (kt + 2 < nk) {
      ga += 64;
      GL(p)
    }
    BL(1, kt + 1)
    COMPUTE(0, 0)
    SL(q, 1)
    __syncthreads();
    if (kt + 3 < nk) {
      ga += 64;
      GL(q)
    }
    if (kt + 2 < nk) {
      BL(0, kt + 2)
    }
    COMPUTE(1, 1)
    if (kt + 2 < nk) {
      SL(p, 0)
    }
    __syncthreads();
  }
#undef GL
#undef SL
#undef BL
#undef COMPUTE
}


#define ELD 136
template <bool TRANS>
__device__ __forceinline__ void stage_tile(bfraw* sT, const f32x16 (&acc)[4]) {
  const int tid_ = otid(); const int lane = tid_ & 63, wave = tid_ >> 6, r = lane & 31, h = lane >> 5;
#pragma unroll
  for (int mi = 0; mi < 4; ++mi)
#pragma unroll
    for (int g = 0; g < 4; ++g) {
      const int lrow = TRANS ? (mi * 32 + r) : (wave * 32 + r);
      const int lcol = TRANS ? (wave * 32 + 8 * g + 4 * h) : (mi * 32 + 8 * g + 4 * h);
      *(uint2*)(sT + lrow * ELD + lcol) =
          make_uint2(pack2(acc[mi][4 * g + 0], acc[mi][4 * g + 1]), pack2(acc[mi][4 * g + 2], acc[mi][4 * g + 3]));
    }
}

__device__ __forceinline__ int xcd_remap(int t, int T) { return (T & 7) ? t : (t & 7) * (T >> 3) + (t >> 3); }

__device__ __forceinline__ void grouped_tile(int t, int MT, int NT, int& mt, int& nt) {
  const int nig = 8 * NT, gid = t / nig, fm = gid * 8, gsz = min(MT - fm, 8), rem = t - gid * nig;
  mt = fm + rem % gsz;
  nt = rem / gsz;
}

__device__ __forceinline__ void rowinfo(int row, int& b, int& kpos, int& l, bool& isctx) {
  if (row < NLAT) {
    b = row >> 11;
    l = row & 2047;
    kpos = CTX + l;
    isctx = false;
  } else {
    int r2 = row - NLAT;
    b = r2 >> 8;
    l = r2 & 255;
    kpos = l;
    isctx = true;
  }
}
__device__ __forceinline__ int keyrow(int b, int kpos) { return kpos < CTX ? NLAT + b * CTX + kpos : b * SEQ + (kpos - CTX); }

__device__ void conv_weight_tile(const float* __restrict__ src, int Ksz, int Nsz, bfraw* __restrict__ dst, int kt, int nt,
                                 const float* __restrict__ kscale, float* sT, bool kvperm = false) {
  const int tid = otid();
  __syncthreads();
#pragma unroll
  for (int i = 0; i < 4; ++i) {
    const int idx = tid + 256 * i;
    const int k = idx >> 4, n4 = (idx & 15) * 4;
    const int gk = kt * 64 + k, gn = nt * 64 + n4;
    float4 v = make_float4(0.f, 0.f, 0.f, 0.f);
    if (gn < Nsz) {
      v = *(const float4*)(src + (size_t)gk * Nsz + gn);
      if (kscale) {
        const float sc = kscale[gk];
        v.x *= sc; v.y *= sc; v.z *= sc; v.w *= sc;
      }
    }
    *(float4*)(sT + k * 68 + n4) = v;
  }
  __syncthreads();
#pragma unroll
  for (int i = 0; i < 2; ++i) {
    const int o = tid + 256 * i;
    const int n = o & 63, ko = o >> 6;
    const float* c = sT + (ko * 8) * 68 + n;
    uint4 w;
    w.x = pack2(c[0 * 68], c[1 * 68]);
    w.y = pack2(c[2 * 68], c[3 * 68]);
    w.z = pack2(c[4 * 68], c[5 * 68]);
    w.w = pack2(c[6 * 68], c[7 * 68]);
    int gn = nt * 64 + n;
    if (kvperm) gn = ((gn >> 6) & 1) * 512 + (gn >> 7) * 64 + (gn & 63);
    const int gk0 = kt * 64 + ko * 8;
    *(uint4*)(dst + ((((size_t)(gn >> 5) * (Ksz >> 4) + (gk0 >> 4)) * 64) + ((gk0 >> 3) & 1) * 32 + (gn & 31)) * 8) = w;
  }
}

__device__ void phase0a(const Params& p, unsigned char* smem, int part) {
  const int tid = otid();
  float* sf = (float*)smem;
  const int T_MOD = 192;
  const int T_IN = 16 * 44, T_OUT = 16 * 16, T_UQ = 4 * 12, T_UKV = 2 * 16, T_PW = 4 * 4;
  const int T_W = T_IN + T_OUT + T_UQ + T_UKV + T_PW;
  const bool split = gridDim.x > (unsigned)(T_MOD + 64);
  if (part == 1 && split) return;
  const int total = (part == 0 && !split) ? T_MOD : T_MOD + 2 * T_W + 1;
  int tstart, tstep;
  if (part == 0 && split) {
    if ((int)blockIdx.x < T_MOD) { tstart = blockIdx.x; tstep = 1 << 30; }
    else { tstart = T_MOD + ((int)blockIdx.x - T_MOD); tstep = (int)gridDim.x - T_MOD; }
  } else {
    tstart = blockIdx.x + (part == 0 ? 0 : T_MOD);
    tstep = gridDim.x;
  }
  for (int t = tstart; t < total && t >= 0; t = (tstep == (1 << 30)) ? total : t + tstep) {
    if (t < T_MOD) {
      const int l = t / 96, jt = t % 96;
      __syncthreads();
      for (int i = tid; i < 9 * 1024; i += 256) {
        int rr = i >> 10, k = i & 1023;
        float cv = rr < 8 ? p.c[rr * 1024 + k] : p.c_ctx[k];
        sf[i] = siluf(cv);
      }
      __syncthreads();
      const int col = tid & 31, kg = tid >> 5;
      float a[9];
#pragma unroll
      for (int rr = 0; rr < 9; ++rr) a[rr] = 0.f;
      const float* w = p.w_mod + (size_t)l * 1024 * 3072 + jt * 32 + col;
      for (int kb = kg * 128; kb < kg * 128 + 128; kb += 16) {
        float wv[16];
#pragma unroll
        for (int u = 0; u < 16; ++u) wv[u] = w[(size_t)(kb + u) * 3072];
#pragma unroll
        for (int u = 0; u < 16; ++u)
#pragma unroll
          for (int rr = 0; rr < 9; ++rr) a[rr] += sf[rr * 1024 + kb + u] * wv[u];
      }
      float* sR = sf + 9 * 1024;
#pragma unroll
      for (int rr = 0; rr < 9; ++rr) sR[(kg * 9 + rr) * 32 + col] = a[rr];
      __syncthreads();
      for (int i = tid; i < 288; i += 256) {
        int rr = i >> 5, cc = i & 31;
        float s = 0.f;
        for (int g = 0; g < 8; ++g) s += sR[(g * 9 + rr) * 32 + cc];
        s += p.b_mod[l * 3072 + jt * 32 + cc];
        p.mod[((size_t)l * 9 + rr) * 3072 + jt * 32 + cc] = s;
      }
    } else if (t < T_MOD + 2 * T_W) {
      int tt = t - T_MOD;
      const int l = tt / T_W;
      tt %= T_W;
      if (tt < T_IN) {
        conv_weight_tile(p.w_in + (size_t)l * 1024 * INC, 1024, INC, p.wt_in + (size_t)l * INCP * 1024, tt / 44, tt % 44, nullptr, sf);
      } else if ((tt -= T_IN) < T_OUT) {
        conv_weight_tile(p.w_out + (size_t)l * 1024 * 1024, 1024, 1024, p.wt_out + (size_t)l * 1024 * 1024, tt / 16, tt % 16, nullptr, sf);
      } else if ((tt -= T_OUT) < T_UQ) {
        conv_weight_tile(p.w_uq + (size_t)l * 256 * 768, 256, 768, p.wt_uq + (size_t)l * 768 * 256, tt / 12, tt % 12, p.g_q + l * 256, sf);
      } else if ((tt -= T_UQ) < T_UKV) {
        conv_weight_tile(p.w_ukv + (size_t)l * 128 * 1024, 128, 1024, p.wt_ukv + (size_t)l * 1024 * 128, tt / 16, tt % 16, p.g_kv + l * 128, sf, true);
      } else {
        tt -= T_UKV;
        conv_weight_tile(p.pw + (size_t)l * 256 * 256, 256, 256, p.wt_pw + (size_t)l * 256 * 256, tt / 4, tt % 4, nullptr, sf);
      }
    } else {
      for (int i = tid; i < 64 * 8; i += 256) {
        int pos = i >> 3, f = i & 7;
        float inv = powf(10000.0f, -(float)(2 * f) / 16.0f);
        float ang = (float)pos * inv;
        p.tabA[i] = make_float2(cosf(ang), sinf(ang));
      }
      for (int i = tid; i < 64 * 16; i += 256) {
        int pos = i >> 4, f = i & 15;
        float inv = powf(10000.0f, -(float)(2 * f) / 32.0f);
        float ang = (float)pos * inv;
        p.tabB[i] = make_float2(cosf(ang), sinf(ang));
      }
    }
  }
}

__device__ void phase_rows(const Params& p, int layer, bool is_prep) {
  const int tid_ = otid(); const int lane = tid_ & 63, wave = tid_ >> 6;
  const int gw = blockIdx.x * 4 + wave, nw = gridDim.x * 4;
  const bool last = (!is_prep) && (layer == 1);
  const int nrows = last ? NLAT : NROW;
  const bfraw* Y = p.P;
  float4 cx[4];
  uint2 cy[4];
#define ROW_XIN(rw) ((is_prep || layer == 0) ? ((rw) >= NLAT ? p.ctx + (size_t)((rw) - NLAT) * DM : p.x + (size_t)(rw) * DM) \
                                             : (const float*)p.out + (size_t)(rw) * DM)
  if (gw < nrows) {
    const float* xi = ROW_XIN(gw);
#pragma unroll
    for (int i = 0; i < 4; ++i) {
      cx[i] = *(const float4*)(xi + i * 256 + lane * 4);
      if (!is_prep) cy[i] = *(const uint2*)(Y + (size_t)gw * DM + i * 256 + lane * 4);
    }
  }
  for (int row = gw; row < nrows; row += nw) {
    int b, kpos, l;
    bool isctx;
    rowinfo(row, b, kpos, l, isctx);
    const int mrow = isctx ? 8 : b;
    float* xout = nullptr;
    if (!is_prep) xout = (layer == 0) ? (isctx ? p.HC1 + (size_t)(row - NLAT) * DM : p.out + (size_t)row * DM) : p.out + (size_t)row * DM;
    float4 nx[4];
    uint2 ny[4];
    const int nrow = row + nw;
    if (nrow < nrows) {
      const float* xi = ROW_XIN(nrow);
#pragma unroll
      for (int i = 0; i < 4; ++i) {
        nx[i] = *(const float4*)(xi + i * 256 + lane * 4);
        if (!is_prep) ny[i] = *(const uint2*)(Y + (size_t)nrow * DM + i * 256 + lane * 4);
      }
    }
    float v[16];
#pragma unroll
    for (int i = 0; i < 4; ++i) {
      v[i * 4 + 0] = cx[i].x;
      v[i * 4 + 1] = cx[i].y;
      v[i * 4 + 2] = cx[i].z;
      v[i * 4 + 3] = cx[i].w;
    }
    if (!is_prep) {
      const float* md = p.mod + ((size_t)layer * 9 + mrow) * 3072 + 2048;
      const float* lg = p.ln_g + layer * DM;
      const float* lb = p.ln_b + layer * DM;
      float s = 0.f;
#pragma unroll
      for (int i = 0; i < 4; ++i) {
        float4 g4 = *(const float4*)(md + i * 256 + lane * 4);
        const uint2 y2 = cy[i];
        v[i * 4 + 0] = ALPHA_F * v[i * 4 + 0] + g4.x * lo_bf(y2.x);
        v[i * 4 + 1] = ALPHA_F * v[i * 4 + 1] + g4.y * hi_bf(y2.x);
        v[i * 4 + 2] = ALPHA_F * v[i * 4 + 2] + g4.z * lo_bf(y2.y);
        v[i * 4 + 3] = ALPHA_F * v[i * 4 + 3] + g4.w * hi_bf(y2.y);
      }
#pragma unroll
      for (int i = 0; i < 16; ++i) s += v[i];
      float mu = wave_sum(s) * (1.0f / DM);
      float q = 0.f;
#pragma unroll
      for (int i = 0; i < 16; ++i) {
        float d = v[i] - mu;
        q += d * d;
      }
      float rstd = rsqrtf(wave_sum(q) * (1.0f / DM) + EPSF);
#pragma unroll
      for (int i = 0; i < 4; ++i) {
        float4 g4 = *(const float4*)(lg + i * 256 + lane * 4);
        float4 b4 = *(const float4*)(lb + i * 256 + lane * 4);
        v[i * 4 + 0] = (v[i * 4 + 0] - mu) * rstd * g4.x + b4.x;
        v[i * 4 + 1] = (v[i * 4 + 1] - mu) * rstd * g4.y + b4.y;
        v[i * 4 + 2] = (v[i * 4 + 2] - mu) * rstd * g4.z + b4.z;
        v[i * 4 + 3] = (v[i * 4 + 3] - mu) * rstd * g4.w + b4.w;
        *(float4*)(xout + i * 256 + lane * 4) = make_float4(v[i * 4 + 0], v[i * 4 + 1], v[i * 4 + 2], v[i * 4 + 3]);
      }
    }
    if (!last) {
      const int nl = is_prep ? 0 : layer + 1;
      const float* md = p.mod + ((size_t)nl * 9 + mrow) * 3072;
      float s = 0.f;
#pragma unroll
      for (int i = 0; i < 16; ++i) s += v[i];
      float mu = wave_sum(s) * (1.0f / DM);
      float q = 0.f;
#pragma unroll
      for (int i = 0; i < 16; ++i) {
        float d = v[i] - mu;
        q += d * d;
      }
      float rstd = rsqrtf(wave_sum(q) * (1.0f / DM) + EPSF);
#pragma unroll
      for (int i = 0; i < 4; ++i) {
        float4 sh = *(const float4*)(md + i * 256 + lane * 4);
        float4 sc = *(const float4*)(md + 1024 + i * 256 + lane * 4);
        float u0 = (v[i * 4 + 0] - mu) * rstd * (1.f + sc.x) + sh.x;
        float u1 = (v[i * 4 + 1] - mu) * rstd * (1.f + sc.y) + sh.y;
        float u2 = (v[i * 4 + 2] - mu) * rstd * (1.f + sc.z) + sh.z;
        float u3 = (v[i * 4 + 3] - mu) * rstd * (1.f + sc.w) + sh.w;
        *(uint2*)(p.U + (size_t)row * DM + i * 256 + lane * 4) = make_uint2(pack2(u0, u1), pack2(u2, u3));
      }
    }
#pragma unroll
    for (int i = 0; i < 4; ++i) {
      cx[i] = nx[i];
      cy[i] = ny[i];
    }
  }
#undef ROW_XIN
}

__device__ __forceinline__ void rope16_acc(const Params& p, f32x16& a, int l, int h) {
#pragma unroll
  for (int part = 0; part < 2; ++part) {
    const int pos = part ? (l & 63) : (l >> 6);
#pragma unroll
    for (int q = 0; q < 4; ++q) {
      const int reg = part * 8 + q;
      const float2 cs = p.tabA[pos * 8 + q + 4 * h];
      const float x1 = a[reg], x2 = a[reg + 4];
      a[reg] = x1 * cs.x - x2 * cs.y;
      a[reg + 4] = x1 * cs.y + x2 * cs.x;
    }
  }
}

__device__ void phase1(const Params& p, int layer, unsigned char* smem) {
  const int tid = otid(), lane = tid & 63, wave = tid >> 6, r = lane & 31, h = lane >> 5;
  const int wm = wave >> 1, wn = wave & 1;
  const int NT = 22, MT = NROW / 128;
  const bfraw* W = p.wt_in + (size_t)layer * INCP * 1024;
  bfraw* sT = (bfraw*)smem;
  const int n_lat = (NLAT / 128) * NT;
  const int total = layer == 0 ? MT * NT : n_lat + (NCTX / 128) * 7;
  for (int t0_ = blockIdx.x; t0_ < total; t0_ += gridDim.x) {
    const int t = xcd_remap(t0_, total);
    int mt, nt;
    if (layer == 0) {
      grouped_tile(t, MT, NT, mt, nt);
    } else if (t < n_lat) {
      grouped_tile(t, NLAT / 128, NT, mt, nt);
    } else {
      const int tt = t - n_lat, j = tt % 7;
      mt = NLAT / 128 + tt / 7;
      nt = j < 2 ? 2 + j : 7 + j;
    }
    const int m0 = mt * 128, n0 = nt * 128;
    f32x16 acc[4];
    gemm128<true, 1024>(p.U + (size_t)m0 * DM, DM, W, n0 >> 5, (bfraw*)smem, acc);
    const bool lat = m0 < NLAT;
    const int cg0 = n0 + wave * 32;
    if (lat) {
      if (cg0 >= C_RQ && cg0 < C_RV) {
        const float ksc = cg0 >= C_RK ? 0.125f : 1.0f;
        const int second = ((cg0 - C_RQ) >> 5) & 1;
#pragma unroll
        for (int mi = 0; mi < 4; ++mi) {
          const int l = (m0 + mi * 32 + r) & 2047;
          const int pos = second ? (l & 63) : (l >> 6);
#pragma unroll
          for (int reg = 0; reg < 8; ++reg) {
            const int fi = (reg & 3) + 8 * (reg >> 2) + 4 * h;
            const float2 cs = p.tabB[pos * 16 + fi];
            const float x1 = acc[mi][reg], x2 = acc[mi][reg + 8];
            acc[mi][reg] = (x1 * cs.x - x2 * cs.y) * ksc;
            acc[mi][reg + 8] = (x1 * cs.y + x2 * cs.x) * ksc;
          }
        }
      } else if (cg0 == C_PKR) {
#pragma unroll
        for (int mi = 0; mi < 4; ++mi) rope16_acc(p, acc[mi], (m0 + mi * 32 + r) & 2047, h);
      }
    } else if (cg0 >= C_RK && cg0 < C_RV) {
#pragma unroll
      for (int mi = 0; mi < 4; ++mi)
#pragma unroll
        for (int reg = 0; reg < 16; ++reg) acc[mi][reg] *= 0.125f;
    }
    stage_tile<true>(sT, acc);
    __syncthreads();
#pragma unroll 2
    for (int i = 0; i < 8; ++i) {
      const int chunk = tid + 256 * i;
      const int row = chunk >> 4, cc = (chunk & 15) * 8;
      if (n0 + cc < INC) *(uint4*)(p.P + (size_t)(m0 + row) * INC + n0 + cc) = *(const uint4*)(sT + row * ELD + cc);
    }
    __syncthreads();
  }
}

template <int NCOL>
__device__ __forceinline__ void row_rstd(const bfraw* __restrict__ src, int ld, float* sR) {
  const int tid = otid();
  const int row = tid >> 1, half = tid & 1;
  constexpr int PER = NCOL >> 1, NL = PER >> 3;
  const bfraw* s = src + (size_t)row * ld + half * PER;
  uint4 u[NL];
#pragma unroll
  for (int i = 0; i < NL; ++i) u[i] = *(const uint4*)(s + i * 8);
  float q0 = 0.f, q1 = 0.f, q2 = 0.f, q3 = 0.f;
#pragma unroll
  for (int i = 0; i < NL; ++i) {
    float a;
    a = lo_bf(u[i].x); q0 += a * a; a = hi_bf(u[i].x); q1 += a * a;
    a = lo_bf(u[i].y); q2 += a * a; a = hi_bf(u[i].y); q3 += a * a;
    a = lo_bf(u[i].z); q0 += a * a; a = hi_bf(u[i].z); q1 += a * a;
    a = lo_bf(u[i].w); q2 += a * a; a = hi_bf(u[i].w); q3 += a * a;
  }
  float q = (q0 + q1) + (q2 + q3);
  q += __shfl_xor(q, 1);
  if (half == 0) sR[row] = rsqrtf(q / (float)NCOL + EPSF);
}

__device__ void task_qup(const Params& p, int layer, int mt, int nt, unsigned char* smem) {
  const int tid = otid(), lane = tid & 63, wave = tid >> 6, r = lane & 31, h = lane >> 5;
  const int wm = wave >> 1, wn = wave & 1;
  const int m0 = mt * 128, n0 = nt * 128;
  float* sR = (float*)(smem + GEMM_LDS);
  bfraw* sT = (bfraw*)smem;
  __syncthreads();
  row_rstd<256>(p.P + (size_t)m0 * INC + C_PQ, INC, sR);
  f32x16 acc[4];
  gemm128<true, 256>(p.P + (size_t)m0 * INC + C_PQ, INC, p.wt_uq + (size_t)layer * 768 * 256, n0 >> 5, (bfraw*)smem, acc);
  const bool lat = m0 < NLAT;
  const float qs = 0.10206207261596577f * 1.4426950408889634f;
  const int ctile = (n0 + wave * 32) >> 5;
#pragma unroll
  for (int mi = 0; mi < 4; ++mi) {
    const int rl = mi * 32 + r;
    const float sc = sR[rl] * qs;
#pragma unroll
    for (int reg = 0; reg < 16; ++reg) acc[mi][reg] *= sc;
    if (lat && (ctile % 3) == 2) rope16_acc(p, acc[mi], (m0 + rl) & 2047, h);
  }
  stage_tile<true>(sT, acc);
  __syncthreads();
  int b, kpos0, l0;
  bool isctx;
  rowinfo(m0, b, kpos0, l0, isctx);
#pragma unroll 2
  for (int i = 0; i < 8; ++i) {
    const int chunk = tid + 256 * i;
    const int row = chunk >> 4, cc = (chunk & 15) * 8;
    const int c = n0 + cc;
    const int head = c / 96, d = c % 96;
    *(uint4*)(p.Q + (((size_t)b * 8 + head) * LKEYS + kpos0 + row) * 96 + d) = *(const uint4*)(sT + row * ELD + cc);
  }
}

__device__ void task_kvup(const Params& p, int layer, int mt, int nt, unsigned char* smem) {
  const int tid = otid(), lane = tid & 63, wave = tid >> 6, r = lane & 31, h = lane >> 5;
  const int wm = wave >> 1;
  const int m0 = mt * 128, n0 = nt * 128;
  float* sR = (float*)(smem + GEMM_LDS);
  bfraw* sT = (bfraw*)smem;
  __syncthreads();
  row_rstd<128>(p.P + (size_t)m0 * INC + C_PKV, INC, sR);
  f32x16 acc[4];
  int b, kpos0, l0;
  bool isctx;
  rowinfo(m0, b, kpos0, l0, isctx);
  const bfraw* A = p.P + (size_t)m0 * INC + C_PKV;
  const bfraw* W = p.wt_ukv + (size_t)layer * 1024 * 128;
  if (nt == 0) {
#pragma unroll
    for (int i = 0; i < 2; ++i) {
      const int chunk = tid + 256 * i;
      const int row = chunk >> 2, cc = (chunk & 3) * 8;
      *(uint4*)(p.KR + ((size_t)b * LKEYS + kpos0 + row) * 32 + cc) = *(const uint4*)(p.P + (size_t)(m0 + row) * INC + C_PKR + cc);
    }
  }
  if (nt < 4) {
    gemm128<true, 128>(A, INC, W, n0 >> 5, (bfraw*)smem, acc);
#pragma unroll
    for (int mi = 0; mi < 4; ++mi) {
      const float sc = sR[mi * 32 + r];
#pragma unroll
      for (int reg = 0; reg < 16; ++reg) acc[mi][reg] *= sc;
    }
    stage_tile<true>(sT, acc);
    __syncthreads();
#pragma unroll 2
    for (int i = 0; i < 8; ++i) {
      const int chunk = tid + 256 * i;
      const int row = chunk >> 4, cc = (chunk & 15) * 8;
      const int head = nt * 2 + (cc >> 6), d = cc & 63;
      *(uint4*)(p.KN + (((size_t)b * 8 + head) * LKEYS + kpos0 + row) * 64 + d) = *(const uint4*)(sT + row * ELD + cc);
    }
  } else {
    gemm128<false, 128>(A, INC, W, n0 >> 5, (bfraw*)smem, acc);
#pragma unroll
    for (int mi = 0; mi < 4; ++mi)
#pragma unroll
      for (int reg = 0; reg < 16; ++reg) acc[mi][reg] *= sR[mi * 32 + (reg & 3) + 8 * (reg >> 2) + 4 * h];
    stage_tile<false>(sT, acc);
    __syncthreads();
#pragma unroll 2
    for (int i = 0; i < 8; ++i) {
      const int chunk = tid + 256 * i;
      const int crow = chunk >> 4, cc = (chunk & 15) * 8;
      const int head = (nt - 4) * 2 + (crow >> 6), d = crow & 63;
      *(uint4*)(p.VT + (((size_t)b * 8 + head) * 64 + d) * LKEYS + kpos0 + cc) = *(const uint4*)(sT + crow * ELD + cc);
    }
  }
}

__device__ __forceinline__ int chunk_row0(int b, int c) { return c < 2 ? NLAT + b * CTX + c * 128 : b * SEQ + (c - 2) * 128; }
__device__ __forceinline__ float log2_sigmoid(float x) { return -log1pf(expf(-x)) * 1.4426950408889634f; }

#define TLD 136
__device__ void task_chunkstate(const Params& p, int layer, int b, int hd, int c, unsigned char* smem) {
  const int tid = otid(), lane = tid & 63, wave = tid >> 6, r = lane & 31, h = lane >> 5;
  bfraw* sKf = (bfraw*)smem;
  bfraw* sKb = sKf + 64 * TLD;
  bfraw* sV = sKb + 64 * TLD;
  const int R0 = chunk_row0(b, c);
  const float lgf = log2_sigmoid(p.dec_f[layer * 4 + hd]);
  const float lgb = log2_sigmoid(p.dec_b[layer * 4 + hd]);
  __syncthreads();
  {
    const int tok = tid >> 1, d0 = (tid & 1) * 32;
    const bfraw* kp = p.P + (size_t)(R0 + tok) * INC + C_RK + hd * 64 + d0;
    const bfraw* vp = p.P + (size_t)(R0 + tok) * INC + C_RV + hd * 64 + d0;
    const float wf = exp2f(lgf * (float)(127 - tok));
    const float wb = exp2f(lgb * (float)tok);
#pragma unroll
    for (int i = 0; i < 4; ++i) {
      uint4 ku = *(const uint4*)(kp + i * 8);
      uint4 vu = *(const uint4*)(vp + i * 8);
      unsigned kw[4] = {ku.x, ku.y, ku.z, ku.w};
      unsigned vw[4] = {vu.x, vu.y, vu.z, vu.w};
#pragma unroll
      for (int j = 0; j < 4; ++j) {
        const int d = d0 + i * 8 + j * 2;
        float k0 = lo_bf(kw[j]), k1 = hi_bf(kw[j]);
        sKf[d * TLD + tok] = f2bf(k0 * wf);
        sKf[(d + 1) * TLD + tok] = f2bf(k1 * wf);
        sKb[d * TLD + tok] = f2bf(k0 * wb);
        sKb[(d + 1) * TLD + tok] = f2bf(k1 * wb);
        sV[d * TLD + tok] = (bfraw)(vw[j] & 0xffffu);
        sV[(d + 1) * TLD + tok] = (bfraw)(vw[j] >> 16);
      }
    }
  }
  __syncthreads();
  const int dir = wave >> 1, mi = wave & 1;
  const bfraw* sK = dir ? sKb : sKf;
  f32x16 acc0 = zero16(), acc1 = zero16();
#pragma unroll
  for (int ks = 0; ks < 8; ++ks) {
    Frag a, b0, b1;
    a.u = *(const uint4*)(sK + (mi * 32 + r) * TLD + ks * 16 + h * 8);
    b0.u = *(const uint4*)(sV + (r)*TLD + ks * 16 + h * 8);
    b1.u = *(const uint4*)(sV + (32 + r) * TLD + ks * 16 + h * 8);
    acc0 = mfma32(a, b0, acc0);
    acc1 = mfma32(a, b1, acc1);
  }
  float* dst = p.CST + ((((size_t)b * 4 + hd) * NCHUNK + c) * 2 + dir) * 4096;
#pragma unroll
  for (int reg = 0; reg < 16; ++reg) {
    const int dk = mi * 32 + (reg & 3) + 8 * (reg >> 2) + 4 * h;
    dst[dk * 64 + r] = acc0[reg];
    dst[dk * 64 + 32 + r] = acc1[reg];
  }
}

#define CT 32
#define ALD 264
__device__ void task_conv(const Params& p, int layer, int seqrow0, int L, int t0, unsigned char* smem) {
  const int tid = otid(), lane = tid & 63, wave = tid >> 6, r = lane & 31, h = lane >> 5;
  bfraw* sU = (bfraw*)smem;
  float* sC = (float*)(smem + 31744);
  bfraw* sA = (bfraw*)smem;
  __syncthreads();
  for (int i = tid; i < 62 * 32; i += 256) {
    const int rr = i >> 5, cc = (i & 31) * 8;
    const int tok = t0 - 15 + rr;
    uint4 o = make_uint4(0, 0, 0, 0);
    if (tok >= 0 && tok < L) {
      const bfraw* src = p.P + (size_t)(seqrow0 + tok) * INC + C_GLU + cc;
      uint4 a = *(const uint4*)(src);
      uint4 g = *(const uint4*)(src + 256);
      o.x = pack2(lo_bf(a.x) * sigmf(lo_bf(g.x)), hi_bf(a.x) * sigmf(hi_bf(g.x)));
      o.y = pack2(lo_bf(a.y) * sigmf(lo_bf(g.y)), hi_bf(a.y) * sigmf(hi_bf(g.y)));
      o.z = pack2(lo_bf(a.z) * sigmf(lo_bf(g.z)), hi_bf(a.z) * sigmf(hi_bf(g.z)));
      o.w = pack2(lo_bf(a.w) * sigmf(lo_bf(g.w)), hi_bf(a.w) * sigmf(hi_bf(g.w)));
    }
    *(uint4*)(sU + rr * 256 + cc) = o;
  }
  __syncthreads();
  {
    const int ch = tid;
    float w[31];
#pragma unroll
    for (int j = 0; j < 31; ++j) w[j] = p.dw[((size_t)layer * 31 + j) * 256 + ch];
    const float bias = p.dw_b[layer * 256 + ch];
    for (int t = 0; t < CT; ++t) {
      float a = bias;
#pragma unroll
      for (int j = 0; j < 31; ++j) a += w[j] * bf2f(sU[(t + j) * 256 + ch]);
      sC[t * 256 + ch] = a;
    }
  }
  __syncthreads();
  {
    const float4 g4 = *(const float4*)(p.cln_g + layer * 256 + lane * 4);
    const float4 b4 = *(const float4*)(p.cln_b + layer * 256 + lane * 4);
#pragma unroll
    for (int i = 0; i < 8; ++i) {
      const int t = wave * 8 + i;
      float4 v = *(const float4*)(sC + t * 256 + lane * 4);
      float mu = wave_sum(v.x + v.y + v.z + v.w) * (1.f / 256.f);
      float dx = v.x - mu, dy = v.y - mu, dz = v.z - mu, dw_ = v.w - mu;
      float rstd = rsqrtf(wave_sum(dx * dx + dy * dy + dz * dz + dw_ * dw_) * (1.f / 256.f) + EPSF);
      float y0 = siluf(dx * rstd * g4.x + b4.x), y1 = siluf(dy * rstd * g4.y + b4.y);
      float y2 = siluf(dz * rstd * g4.z + b4.z), y3 = siluf(dw_ * rstd * g4.w + b4.w);
      *(uint2*)(sA + t * ALD + lane * 4) = make_uint2(pack2(y0, y1), pack2(y2, y3));
    }
  }
  __syncthreads();
  {
    const bfraw* W = p.wt_pw + (size_t)layer * 256 * 256;
    f32x16 acc0 = zero16(), acc1 = zero16();
#pragma unroll 4
    for (int ks = 0; ks < 16; ++ks) {
      Frag a, b0, b1;
      a.u = *(const uint4*)(sA + r * ALD + ks * 16 + h * 8);
      b0.u = *(const uint4*)(W + ((size_t)((wave * 2 + 0) * 16 + ks) * 64 + lane) * 8);
      b1.u = *(const uint4*)(W + ((size_t)((wave * 2 + 1) * 16 + ks) * 64 + lane) * 8);
      acc0 = mfma32(b0, a, acc0);
      acc1 = mfma32(b1, a, acc1);
    }
    const size_t row = (size_t)seqrow0 + t0 + r;
    const bfraw* gp = p.P + row * INC + C_GCONV + wave * 64;
    bfraw* op = p.U + row * DM + 768 + wave * 64;
    const float* pbp = p.pw_b + layer * 256 + wave * 64;
#pragma unroll
    for (int g = 0; g < 4; ++g) {
      const int n = 8 * g + 4 * h;
      uint2 gu = *(const uint2*)(gp + n);
      float4 b4 = *(const float4*)(pbp + n);
      float x0 = (acc0[g * 4 + 0] + b4.x) * siluf(lo_bf(gu.x));
      float x1 = (acc0[g * 4 + 1] + b4.y) * siluf(hi_bf(gu.x));
      float x2 = (acc0[g * 4 + 2] + b4.z) * siluf(lo_bf(gu.y));
      float x3 = (acc0[g * 4 + 3] + b4.w) * siluf(hi_bf(gu.y));
      *(uint2*)(op + n) = make_uint2(pack2(x0, x1), pack2(x2, x3));
      gu = *(const uint2*)(gp + 32 + n);
      b4 = *(const float4*)(pbp + 32 + n);
      x0 = (acc1[g * 4 + 0] + b4.x) * siluf(lo_bf(gu.x));
      x1 = (acc1[g * 4 + 1] + b4.y) * siluf(hi_bf(gu.x));
      x2 = (acc1[g * 4 + 2] + b4.z) * siluf(lo_bf(gu.y));
      x3 = (acc1[g * 4 + 3] + b4.w) * siluf(hi_bf(gu.y));
      *(uint2*)(op + 32 + n) = make_uint2(pack2(x0, x1), pack2(x2, x3));
    }
  }
}

#ifdef ONLYT
#define ENT(n) ((n) == ONLYT)
#else
#define ENT(n) true
#endif
__device__ void phase2(const Params& p, int layer, unsigned char* smem) {
  const bool need_ctx = (layer == 0);
  const int n_q = (need_ctx ? NROW / 128 : NLAT / 128) * 6;
  const int n_kv = (NROW / 128) * 8;
  const int n_cs = NB * 4 * NCHUNK;
  const int n_cv = NB * 64 + (need_ctx ? NB * 8 : 0);
  const int total = n_q + n_kv + n_cs + n_cv;
  for (int t = blockIdx.x; t < total; t += gridDim.x) {
    int tt = t;
    if (tt < n_cv) {
      int seqrow0, L, t0;
      if (tt < NB * 64) {
        seqrow0 = (tt >> 6) * SEQ; L = SEQ; t0 = (tt & 63) * CT;
      } else {
        tt -= NB * 64;
        seqrow0 = NLAT + (tt >> 3) * CTX; L = CTX; t0 = (tt & 7) * CT;
      }
      if (ENT(3)) task_conv(p, layer, seqrow0, L, t0, smem);
    } else if ((tt -= n_cv) < n_kv) {
      tt = xcd_remap(tt, n_kv);
      if (ENT(0)) task_kvup(p, layer, tt / 8, tt % 8, smem);
    } else if ((tt -= n_kv) < n_q) {
      tt = xcd_remap(tt, n_q);
      if (ENT(1)) task_qup(p, layer, tt / 6, tt % 6, smem);
    } else {
      tt -= n_q;
      tt = xcd_remap(tt, n_cs);
      const int hd_ = tt & 3, bc = tt >> 2;
      const int c = bc % NCHUNK;
      const int b_ = bc / NCHUNK;
      if (ENT(2)) task_chunkstate(p, layer, b_, hd_, c, smem);
    }
  }
}

#define KLD 104
#define VLD 72
__device__ __forceinline__ float fexp2(float x) { return __builtin_amdgcn_exp2f(x); }
__device__ __forceinline__ float xhalf_max(float x) {
  auto t = __builtin_amdgcn_permlane32_swap(__float_as_uint(x), __float_as_uint(x), false, false);
  return fmaxf(__uint_as_float(t[0]), __uint_as_float(t[1]));
}
__device__ __forceinline__ float xhalf_sum(float x) {
  auto t = __builtin_amdgcn_permlane32_swap(__float_as_uint(x), __float_as_uint(x), false, false);
  return __uint_as_float(t[0]) + __uint_as_float(t[1]);
}

__device__ void task_attn(const Params& p, int b, int hd, int qpos0, int nkeys, unsigned char* smem) {
  const int tid = otid(), lane = tid & 63, wave = tid >> 6, r = lane & 31, h = lane >> 5;
  bfraw* sK = (bfraw*)smem;
  bfraw* sV = sK + 2 * 64 * KLD;
  const size_t bh = (size_t)b * 8 + hd;
  const bfraw* KNp = p.KN + bh * LKEYS * 64;
  const bfraw* VTp = p.VT + bh * 64 * LKEYS;
  const int qpos = qpos0 + wave * 32 + r;
  Frag qf0, qf1, qf2, qf3, qf4, qf5;
  {
    const bfraw* qp = p.Q + (bh * LKEYS + qpos) * 96 + h * 8;
    qf0.u = *(const uint4*)(qp);
    qf1.u = *(const uint4*)(qp + 16);
    qf2.u = *(const uint4*)(qp + 32);
    qf3.u = *(const uint4*)(qp + 48);
    qf4.u = *(const uint4*)(qp + 64);
    qf5.u = *(const uint4*)(qp + 80);
  }
  const int k0key = tid / 12, k0cc = tid % 12;
  const int k1key = (tid + 256) / 12, k1cc = (tid + 256) % 12;
  const int k2key = (tid + 512) / 12, k2cc = (tid + 512) % 12;
  const int vd = tid >> 3, vcc = tid & 7;
  uint4 pk0, pk1, pk2, pv0, pv1;
#define KSRC(key, cc, key0)                                                                     \
  ((cc) < 8 ? (KNp + (size_t)((key0) + (key)) * 64 + (cc) * 8)                                   \
            : (p.KR + ((size_t)b * LKEYS + (key0) + (key)) * 32 + ((cc) - 8) * 8))
#define GLOAD(S, key0)                                                    \
  do {                                                                    \
    S##k0 = *(const uint4*)KSRC(k0key, k0cc, key0);                       \
    S##k1 = *(const uint4*)KSRC(k1key, k1cc, key0);                       \
    S##k2 = *(const uint4*)KSRC(k2key, k2cc, key0);                       \
    S##v0 = *(const uint4*)(VTp + (size_t)vd * LKEYS + (key0) + vcc * 8);        \
    S##v1 = *(const uint4*)(VTp + (size_t)(vd + 32) * LKEYS + (key0) + vcc * 8); \
  } while (0)
#define SSTORE(S, buf)                                                       \
  do {                                                                       \
    *(uint4*)(sK + (buf) * 64 * KLD + k0key * KLD + k0cc * 8) = S##k0;       \
    *(uint4*)(sK + (buf) * 64 * KLD + k1key * KLD + k1cc * 8) = S##k1;       \
    *(uint4*)(sK + (buf) * 64 * KLD + k2key * KLD + k2cc * 8) = S##k2;       \
    *(uint4*)(sV + (buf) * 64 * VLD + vd * VLD + vcc * 8) = S##v0;           \
    *(uint4*)(sV + (buf) * 64 * VLD + (vd + 32) * VLD + vcc * 8) = S##v1;    \
  } while (0)
#define ATT_TILE(buf)                                                              \
  {                                                                                \
    const bfraw* cK = sK + (buf) * 64 * KLD + r * KLD + h * 8;                     \
    const bfraw* cV = sV + (buf) * 64 * VLD + r * VLD + h * 4;                     \
    Frag ka[6], kb[6], va[4], vb[4];                                               \
    _Pragma("unroll") for (int ks = 0; ks < 6; ++ks) {                             \
      ka[ks].u = *(const uint4*)(cK + ks * 16);                                    \
      kb[ks].u = *(const uint4*)(cK + 32 * KLD + ks * 16);                         \
    }                                                                              \
    __builtin_amdgcn_sched_barrier(0);                                             \
    f32x16 s0 = zero16(), s1 = zero16();                                           \
    s0 = mfma32(ka[0], qf0, s0); s1 = mfma32(kb[0], qf0, s1);                      \
    s0 = mfma32(ka[1], qf1, s0); s1 = mfma32(kb[1], qf1, s1);                      \
    s0 = mfma32(ka[2], qf2, s0); s1 = mfma32(kb[2], qf2, s1);                      \
    s0 = mfma32(ka[3], qf3, s0); s1 = mfma32(kb[3], qf3, s1);                      \
    s0 = mfma32(ka[4], qf4, s0); s1 = mfma32(kb[4], qf4, s1);                      \
    s0 = mfma32(ka[5], qf5, s0); s1 = mfma32(kb[5], qf5, s1);                      \
    float mx = fmaxf(s0[0], s1[0]);                                                \
    _Pragma("unroll") for (int i = 1; i < 16; ++i) mx = fmaxf(mx, fmaxf(s0[i], s1[i])); \
    mx = xhalf_max(mx);                                            \
    if (__builtin_amdgcn_ballot_w64(mx > m + 8.0f) != 0ull) {                      \
        \
      const float mn = fmaxf(m, mx);                                               \
      const float al = fexp2(m - mn);                                              \
      m = mn;                                                                      \
      lsum *= al;                                                                  \
      _Pragma("unroll") for (int i = 0; i < 16; ++i) {                             \
        o0[i] *= al;                                                               \
        o1[i] *= al;                                                               \
      }                                                                            \
    }                                                                              \
    float ps;                                                                      \
    {                                                                              \
      const f2v mm = {m, m};                                                       \
      f2v ps2 = {0.f, 0.f};                                                        \
      _Pragma("unroll") for (int i = 0; i < 16; i += 2) {                          \
        f2v d0 = {s0[i], s0[i + 1]};                                               \
        f2v d1 = {s1[i], s1[i + 1]};                                               \
        d0 -= mm;                                                                  \
        d1 -= mm;                                                                  \
        d0.x = fexp2(d0.x); d0.y = fexp2(d0.y);                                    \
        d1.x = fexp2(d1.x); d1.y = fexp2(d1.y);                                    \
        ps2 += d0;                                                                 \
        ps2 += d1;                                                                 \
        s0[i] = d0.x; s0[i + 1] = d0.y;                                            \
        s1[i] = d1.x; s1[i + 1] = d1.y;                                            \
      }                                                                            \
      ps = ps2.x + ps2.y;                                                          \
    }                                                                              \
    _Pragma("unroll") for (int s = 0; s < 4; ++s) {                                \
      va[s].d[0] = *(const uint2*)(cV + s * 16);                                   \
      va[s].d[1] = *(const uint2*)(cV + s * 16 + 8);                               \
      vb[s].d[0] = *(const uint2*)(cV + 32 * VLD + s * 16);                        \
      vb[s].d[1] = *(const uint2*)(cV + 32 * VLD + s * 16 + 8);                    \
    }                                                                              \
    lsum += ps;                                                                    \
    _Pragma("unroll") for (int s = 0; s < 2; ++s) {                                \
      Frag pb;                                                                     \
      pb.w[0] = pack2(s0[8 * s + 0], s0[8 * s + 1]);                               \
      pb.w[1] = pack2(s0[8 * s + 2], s0[8 * s + 3]);                               \
      pb.w[2] = pack2(s0[8 * s + 4], s0[8 * s + 5]);                               \
      pb.w[3] = pack2(s0[8 * s + 6], s0[8 * s + 7]);                               \
      o0 = mfma32(va[s], pb, o0);                                                  \
      o1 = mfma32(vb[s], pb, o1);                                                  \
    }                                                                              \
    _Pragma("unroll") for (int s = 0; s < 2; ++s) {                                \
      Frag pb;                                                                     \
      pb.w[0] = pack2(s1[8 * s + 0], s1[8 * s + 1]);                               \
      pb.w[1] = pack2(s1[8 * s + 2], s1[8 * s + 3]);                               \
      pb.w[2] = pack2(s1[8 * s + 4], s1[8 * s + 5]);                               \
      pb.w[3] = pack2(s1[8 * s + 6], s1[8 * s + 7]);                               \
      o0 = mfma32(va[2 + s], pb, o0);                                              \
      o1 = mfma32(vb[2 + s], pb, o1);                                              \
    }                                                                              \
  }
#define QK(ks, qf)
  f32x16 o0 = zero16(), o1 = zero16();
  float m = -1e30f, lsum = 0.f;
  const int nt = nkeys >> 6;
  __syncthreads();
  GLOAD(p, 0);
  SSTORE(p, 0);
  __syncthreads();
  for (int kt = 0; kt < nt; kt += 2) {
    GLOAD(p, (kt + 1) * 64);
    ATT_TILE(0)
    SSTORE(p, 1);
    __syncthreads();
    if (kt + 2 < nt) GLOAD(p, (kt + 2) * 64);
    ATT_TILE(1)
    if (kt + 2 < nt) SSTORE(p, 0);
    __syncthreads();
  }
#undef QK
#undef ATT_TILE
#undef GLOAD
#undef SSTORE
#undef KSRC
  lsum = xhalf_sum(lsum);
  const float inv = 1.0f / lsum;
  const int row = keyrow(b, qpos);
  const bfraw* gp = p.P + (size_t)row * INC + C_GMLA + hd * 64;
  bfraw* op = p.U + (size_t)row * DM + hd * 64;
#pragma unroll
  for (int g = 0; g < 4; ++g) {
    const int d = 8 * g + 4 * h;
    uint2 gu = *(const uint2*)(gp + d);
    float x0 = o0[g * 4 + 0] * inv * siluf(lo_bf(gu.x));
    float x1 = o0[g * 4 + 1] * inv * siluf(hi_bf(gu.x));
    float x2 = o0[g * 4 + 2] * inv * siluf(lo_bf(gu.y));
    float x3 = o0[g * 4 + 3] * inv * siluf(hi_bf(gu.y));
    *(uint2*)(op + d) = make_uint2(pack2(x0, x1), pack2(x2, x3));
    gu = *(const uint2*)(gp + 32 + d);
    x0 = o1[g * 4 + 0] * inv * siluf(lo_bf(gu.x));
    x1 = o1[g * 4 + 1] * inv * siluf(hi_bf(gu.x));
    x2 = o1[g * 4 + 2] * inv * siluf(lo_bf(gu.y));
    x3 = o1[g * 4 + 3] * inv * siluf(hi_bf(gu.y));
    *(uint2*)(op + 32 + d) = make_uint2(pack2(x0, x1), pack2(x2, x3));
  }
}

__device__ void task_prefix(const Params& p, int layer, int pt) {
  const int tid = otid();
  const int bh = pt >> 4, dir = (pt >> 3) & 1, slice = pt & 7;
  const int hd = bh & 3;
  const float lg = log2_sigmoid(dir ? p.dec_b[layer * 4 + hd] : p.dec_f[layer * 4 + hd]);
  const float cd = exp2f(lg * 128.f);
  const size_t eoff = ((size_t)bh * NCHUNK) * 2 * 4096 + (size_t)dir * 4096 + slice * 512 + 2 * tid;
  const float* base = p.CST + eoff;
  bfraw* obase = p.PRE + eoff;
  float2 v[1][NCHUNK];
#pragma unroll
  for (int s2 = 0; s2 < NCHUNK; ++s2) {
    const int c2 = dir ? (s2 < 2 ? 1 - s2 : 19 - s2) : s2;
#pragma unroll
    for (int j = 0; j < 1; ++j) v[j][s2] = *(const float2*)(base + (size_t)c2 * 2 * 4096 + j * 512);
  }
  float2 S[1] = {make_float2(0.f, 0.f)};
#pragma unroll
  for (int s2 = 0; s2 < NCHUNK; ++s2) {
    const int c2 = dir ? (s2 < 2 ? 1 - s2 : 19 - s2) : s2;
#pragma unroll
    for (int j = 0; j < 1; ++j) {
      __hip_atomic_store((unsigned*)(obase + (size_t)c2 * 2 * 4096 + j * 512), pack2(S[j].x, S[j].y), __ATOMIC_RELAXED,
                         __HIP_MEMORY_SCOPE_AGENT);
      S[j].x = S[j].x * cd + v[j][s2].x;
      S[j].y = S[j].y * cd + v[j][s2].y;
    }
  }
  asm volatile("s_waitcnt vmcnt(0)" ::: "memory");
  __syncthreads();
  if (tid == 0) (void)xb_add(&p.bar[XCD_BAR_WORDS + layer * 32 + bh], 1u);
}

#define SLD 72
__device__ void task_retout(const Params& p, int layer, int b, int hd, int c, unsigned char* smem) {
  const int tid = otid(), lane = tid & 63, wave = tid >> 6, r = lane & 31, h = lane >> 5;
  bfraw* sV = (bfraw*)smem;
  bfraw* sSf = sV + 64 * TLD;
  bfraw* sSb = sSf + 64 * SLD;
  const int R0 = chunk_row0(b, c);
  const float lgf = log2_sigmoid(p.dec_f[layer * 4 + hd]);
  const float lgb = log2_sigmoid(p.dec_b[layer * 4 + hd]);
  const float cdf = exp2f(lgf * 128.f), cdb = exp2f(lgb * 128.f);
  __syncthreads();
  {
    const int tok = tid >> 1, d0 = (tid & 1) * 32;
    const bfraw* vp = p.P + (size_t)(R0 + tok) * INC + C_RV + hd * 64 + d0;
#pragma unroll
    for (int i = 0; i < 4; ++i) {
      uint4 vu = *(const uint4*)(vp + i * 8);
      unsigned vw[4] = {vu.x, vu.y, vu.z, vu.w};
#pragma unroll
      for (int j = 0; j < 4; ++j) {
        const int d = d0 + i * 8 + j * 2;
        sV[d * TLD + tok] = (bfraw)(vw[j] & 0xffffu);
        sV[(d + 1) * TLD + tok] = (bfraw)(vw[j] >> 16);
      }
    }
  }
  {
    unsigned* rdy = &p.bar[XCD_BAR_WORDS + layer * 32 + b * 4 + hd];
    if (tid == 0) {
      XB_SPIN(xb_ld(rdy) < 16u, p.bar);
    }
    __syncthreads();
    const bfraw* pf = p.PRE + ((((size_t)b * 4 + hd) * NCHUNK + c) * 2) * 4096;
#pragma unroll
    for (int j = 0; j < 2; ++j) {
      const int e0 = (tid + 256 * j) * 8;
      const int dk = e0 >> 6, dv0 = e0 & 63;
      const unsigned long long f0 = __hip_atomic_load((unsigned long long*)(pf + e0), __ATOMIC_RELAXED, __HIP_MEMORY_SCOPE_AGENT);
      const unsigned long long f1 = __hip_atomic_load((unsigned long long*)(pf + e0 + 4), __ATOMIC_RELAXED, __HIP_MEMORY_SCOPE_AGENT);
      const unsigned long long b0 = __hip_atomic_load((unsigned long long*)(pf + 4096 + e0), __ATOMIC_RELAXED, __HIP_MEMORY_SCOPE_AGENT);
      const unsigned long long b1 = __hip_atomic_load((unsigned long long*)(pf + 4096 + e0 + 4), __ATOMIC_RELAXED, __HIP_MEMORY_SCOPE_AGENT);
      unsigned wf[4] = {(unsigned)f0, (unsigned)(f0 >> 32), (unsigned)f1, (unsigned)(f1 >> 32)};
      unsigned wb[4] = {(unsigned)b0, (unsigned)(b0 >> 32), (unsigned)b1, (unsigned)(b1 >> 32)};
#pragma unroll
      for (int q = 0; q < 4; ++q) {
        sSf[(dv0 + 2 * q) * SLD + dk] = (bfraw)(wf[q] & 0xffffu);
        sSf[(dv0 + 2 * q + 1) * SLD + dk] = (bfraw)(wf[q] >> 16);
        sSb[(dv0 + 2 * q) * SLD + dk] = (bfraw)(wb[q] & 0xffffu);
        sSb[(dv0 + 2 * q + 1) * SLD + dk] = (bfraw)(wb[q] >> 16);
      }
    }
  }
  const int qi = wave * 32 + r;
  Frag qf[4];
  {
    const bfraw* qp = p.P + (size_t)(R0 + qi) * INC + C_RQ + hd * 64 + h * 8;
#pragma unroll
    for (int ks = 0; ks < 4; ++ks) qf[ks].u = *(const uint4*)(qp + ks * 16);
  }
  __syncthreads();
  f32x16 o0, o1;
  {
    f32x16 x0 = zero16(), x1 = zero16();
#pragma unroll
    for (int ks = 0; ks < 4; ++ks) {
      Frag a0, a1;
      a0.u = *(const uint4*)(sSf + r * SLD + ks * 16 + h * 8);
      a1.u = *(const uint4*)(sSf + (32 + r) * SLD + ks * 16 + h * 8);
      x0 = mfma32(a0, qf[ks], x0);
      x1 = mfma32(a1, qf[ks], x1);
    }
    const float sf = exp2f(lgf * (float)(qi + 1));
#pragma unroll
    for (int i = 0; i < 16; ++i) {
      o0[i] = x0[i] * sf;
      o1[i] = x1[i] * sf;
    }
    x0 = zero16();
    x1 = zero16();
#pragma unroll
    for (int ks = 0; ks < 4; ++ks) {
      Frag a0, a1;
      a0.u = *(const uint4*)(sSb + r * SLD + ks * 16 + h * 8);
      a1.u = *(const uint4*)(sSb + (32 + r) * SLD + ks * 16 + h * 8);
      x0 = mfma32(a0, qf[ks], x0);
      x1 = mfma32(a1, qf[ks], x1);
    }
    const float sb = exp2f(lgb * (float)(128 - qi));
#pragma unroll
    for (int i = 0; i < 16; ++i) {
      o0[i] += x0[i] * sb;
      o1[i] += x1[i] * sb;
    }
  }
#pragma unroll 1
  for (int kt = 0; kt < 4; ++kt) {
    f32x16 s = zero16();
    const bfraw* kp = p.P + (size_t)(R0 + kt * 32 + r) * INC + C_RK + hd * 64 + h * 8;
#pragma unroll
    for (int ks = 0; ks < 4; ++ks) {
      Frag a;
      a.u = *(const uint4*)(kp + ks * 16);
      s = mfma32(a, qf[ks], s);
    }
#pragma unroll
    for (int reg = 0; reg < 16; ++reg) {
      const int j = kt * 32 + (reg & 3) + 8 * (reg >> 2) + 4 * h;
      const int d = qi - j;
      const float w = fexp2(d >= 0 ? lgf * (float)d : lgb * (float)(-d));
      s[reg] *= w;
    }
#pragma unroll
    for (int s2 = 0; s2 < 2; ++s2) {
      Frag pb, v0, v1;
      pb.w[0] = pack2(s[8 * s2 + 0], s[8 * s2 + 1]);
      pb.w[1] = pack2(s[8 * s2 + 2], s[8 * s2 + 3]);
      pb.w[2] = pack2(s[8 * s2 + 4], s[8 * s2 + 5]);
      pb.w[3] = pack2(s[8 * s2 + 6], s[8 * s2 + 7]);
      const int ko = kt * 32 + s2 * 16 + h * 4;
      v0.d[0] = *(const uint2*)(sV + r * TLD + ko);
      v0.d[1] = *(const uint2*)(sV + r * TLD + ko + 8);
      v1.d[0] = *(const uint2*)(sV + (32 + r) * TLD + ko);
      v1.d[1] = *(const uint2*)(sV + (32 + r) * TLD + ko + 8);
      o0 = mfma32(v0, pb, o0);
      o1 = mfma32(v1, pb, o1);
    }
  }
  float sm_ = 0.f;
#pragma unroll
  for (int i = 0; i < 16; ++i) sm_ += o0[i] + o1[i];
  sm_ = xhalf_sum(sm_);
  const float mu = sm_ * (1.f / 64.f);
  float q = 0.f;
#pragma unroll
  for (int i = 0; i < 16; ++i) {
    float d0 = o0[i] - mu, d1 = o1[i] - mu;
    q += d0 * d0 + d1 * d1;
  }
  q = xhalf_sum(q);
  const float rstd = rsqrtf(q * (1.f / 64.f) + EPSF);
  const size_t row = (size_t)R0 + qi;
  const bfraw* gp = p.P + row * INC + C_GRET + hd * 64;
  bfraw* op = p.U + row * DM + 512 + hd * 64;
  const float* gg = p.gn_g + layer * 256 + hd * 64;
  const float* gb = p.gn_b + layer * 256 + hd * 64;
#pragma unroll
  for (int dt = 0; dt < 2; ++dt) {
#pragma unroll
    for (int g = 0; g < 4; ++g) {
      const int d = dt * 32 + 8 * g + 4 * h;
      uint2 gu = *(const uint2*)(gp + d);
      float4 g4 = *(const float4*)(gg + d);
      float4 b4 = *(const float4*)(gb + d);
      float x0 = ((dt ? o1[g * 4 + 0] : o0[g * 4 + 0]) - mu) * rstd * g4.x + b4.x;
      float x1 = ((dt ? o1[g * 4 + 1] : o0[g * 4 + 1]) - mu) * rstd * g4.y + b4.y;
      float x2 = ((dt ? o1[g * 4 + 2] : o0[g * 4 + 2]) - mu) * rstd * g4.z + b4.z;
      float x3 = ((dt ? o1[g * 4 + 3] : o0[g * 4 + 3]) - mu) * rstd * g4.w + b4.w;
      x0 *= siluf(lo_bf(gu.x));
      x1 *= siluf(hi_bf(gu.x));
      x2 *= siluf(lo_bf(gu.y));
      x3 *= siluf(hi_bf(gu.y));
      *(uint2*)(op + d) = make_uint2(pack2(x0, x1), pack2(x2, x3));
    }
  }
}

__device__ void phase3(const Params& p, int layer, unsigned char* smem) {
  const bool need_ctx = (layer == 0);
  const int n_pf = 512;
  const int n_at = NB * 8 * 16 + (need_ctx ? NB * 8 * 2 : 0);
  const int n_rt = NB * 4 * (need_ctx ? 18 : 16);
  const int total = n_pf + n_at + n_rt;
  for (int t0_ = blockIdx.x; t0_ < total; t0_ += gridDim.x) {
    if (t0_ < n_pf) {
      task_prefix(p, layer, t0_);
      continue;
    }
    const int t1_ = t0_ - n_pf;
    const int t = t1_ < NB * 8 * 16 ? xcd_remap(t1_, NB * 8 * 16) : t1_;
    if (t < NB * 8 * 16) {
      const int qb = t & 15, bh = t >> 4;
      task_attn(p, bh >> 3, bh & 7, CTX + qb * 128, LKEYS, smem);
    } else if (t < n_at) {
      const int tt = t - NB * 8 * 16;
      const int qb = tt & 1, bh = tt >> 1;
      task_attn(p, bh >> 3, bh & 7, qb * 128, CTX, smem);
    } else {
      const int tt = xcd_remap(t - n_at, n_rt);
      const int nc = need_ctx ? 18 : 16;
      const int hd_ = tt & 3, bc = tt >> 2;
      const int c = bc % nc + (need_ctx ? 0 : 2);
      const int b_ = bc / nc;
      task_retout(p, layer, b_, hd_, c, smem);
    }
  }
}

__device__ void phase4(const Params& p, int layer, unsigned char* smem) {
  const int tid = otid();
  const int MT = (layer == 0 ? NROW : NLAT) / 128, NT = 8;
  const bfraw* W = p.wt_out + (size_t)layer * 1024 * 1024;
  bfraw* Y = p.P;
  bfraw* sT = (bfraw*)smem;
  for (int t0_ = blockIdx.x; t0_ < MT * NT; t0_ += gridDim.x) {
    const int t = xcd_remap(t0_, MT * NT);
    int mt, nt;
    grouped_tile(t, MT, NT, mt, nt);
    const int m0 = mt * 128, n0 = nt * 128;
    f32x16 acc[4];
    gemm128<true, 1024>(p.U + (size_t)m0 * DM, DM, W, n0 >> 5, (bfraw*)smem, acc);
    stage_tile<true>(sT, acc);
    __syncthreads();
#pragma unroll 2
    for (int i = 0; i < 8; ++i) {
      const int chunk = tid + 256 * i;
      const int row = chunk >> 4, cc = (chunk & 15) * 8;
      *(uint4*)(Y + (size_t)(m0 + row) * DM + n0 + cc) = *(const uint4*)(sT + row * ELD + cc);
    }
    __syncthreads();
  }
}


#ifdef ONLY
#define EN(n) ((n) == ONLY)
#else
#define EN(n) true
#endif
__global__ void __launch_bounds__(256, 2) mega(Params p) {
  extern __shared__ __attribute__((aligned(16))) unsigned char smem_dyn[];
  unsigned char* smem = smem_dyn + 16;
  uint4& xb_words = *(uint4*)smem_dyn;
  cg::grid_group grid = cg::this_grid();
  if (threadIdx.x == 0) xb_words = make_uint4(0u, 0u, 0u, 0u);
  __syncthreads();
  XcdBarrier xb = xcd_barrier_post(p.bar, (volatile LAS unsigned*)&xb_words);
  if (p.phase_begin < 0) grid.sync();
  for (int ph = p.phase_begin; ph < p.phase_end; ++ph) {
    if (ph > p.phase_begin) xcd_barrier(xb);
    if (ph == 0) { if (EN(0)) phase0a(p, smem, 0); }
    else if (ph == 1) { if (EN(1)) { phase0a(p, smem, 1); phase_rows(p, 0, true); } }
    else {
      const int layer = (ph - 2) / 5, sub = (ph - 2) % 5;
      if (sub == 0) { if (EN(2)) phase1(p, layer, smem); }
      else if (sub == 1) { if (EN(3)) phase2(p, layer, smem); }
      else if (sub == 2) { if (EN(4)) phase3(p, layer, smem); }
      else if (sub == 3) { if (EN(5)) phase4(p, layer, smem); }
      else { if (EN(6)) phase_rows(p, layer, false); }
    }
  }
}

extern "C" void kernel_launch(void* const* d_in, const int* in_sizes, int n_in, void* d_out, int out_size, void* d_ws,
                              size_t ws_size, hipStream_t stream) {
  static int grid_blocks = 0;
  if (!grid_blocks) {
    int dev = 0, cus = 0, per_cu = 0;
    hipGetDevice(&dev);
    hipDeviceGetAttribute(&cus, hipDeviceAttributeMultiprocessorCount, dev);
    hipFuncSetAttribute((const void*)mega, hipFuncAttributeMaxDynamicSharedMemorySize, DYN_LDS);
    hipOccupancyMaxActiveBlocksPerMultiprocessor(&per_cu, mega, 256, DYN_LDS);
    if (per_cu > 2) per_cu = 2;
    if (per_cu < 1) per_cu = 1;
    grid_blocks = cus * per_cu;
  }
  Params p{};
  const float* const* in = (const float* const*)d_in;
  p.x = in[0]; p.c = in[1]; p.ctx = in[2]; p.c_ctx = in[3]; p.w_mod = in[4]; p.b_mod = in[5]; p.w_in = in[6];
  p.g_q = in[7]; p.w_uq = in[8]; p.g_kv = in[9]; p.w_ukv = in[10]; p.dec_f = in[11]; p.dec_b = in[12];
  p.gn_g = in[13]; p.gn_b = in[14]; p.dw = in[15]; p.dw_b = in[16]; p.cln_g = in[17]; p.cln_b = in[18];
  p.pw = in[19]; p.pw_b = in[20]; p.w_out = in[21]; p.ln_g = in[22]; p.ln_b = in[23];
  p.out = (float*)d_out;
  size_t off = 0;
  auto take = [&](size_t bytes) {
    void* q = (char*)d_ws + off;
    off += (bytes + 255) & ~(size_t)255;
    return q;
  };
  p.wt_in = (bfraw*)take((size_t)2 * INCP * 1024 * 2);
  p.wt_uq = (bfraw*)take((size_t)2 * 768 * 256 * 2);
  p.wt_ukv = (bfraw*)take((size_t)2 * 1024 * 128 * 2);
  p.wt_pw = (bfraw*)take((size_t)2 * 256 * 256 * 2);
  p.wt_out = (bfraw*)take((size_t)2 * 1024 * 1024 * 2);
  p.mod = (float*)take((size_t)2 * 9 * 3072 * 4);
  p.tabA = (float2*)take(64 * 8 * 8);
  p.tabB = (float2*)take(64 * 16 * 8);
  p.U = (bfraw*)take((size_t)NROW * DM * 2);
  p.P = (bfraw*)take((size_t)NROW * INC * 2);
  p.Q = (bfraw*)take((size_t)NB * 8 * LKEYS * 96 * 2);
  p.KN = (bfraw*)take((size_t)NB * 8 * LKEYS * 64 * 2);
  p.VT = (bfraw*)take((size_t)NB * 8 * 64 * LKEYS * 2);
  p.CST = (float*)take((size_t)NB * 4 * NCHUNK * 2 * 4096 * 4);
  p.HC1 = (float*)take((size_t)NCTX * DM * 4);
  p.bar = (unsigned*)take((size_t)(XCD_BAR_WORDS + 64) * 4);
  p.KR = (bfraw*)take((size_t)NB * LKEYS * 32 * 2);
  p.PRE = (bfraw*)take((size_t)NB * 4 * NCHUNK * 2 * 4096 * 2);
  if (off > ws_size) {
    fprintf(stderr, "workspace too small: need %zu have %zu\n", off, ws_size);
    return;
  }
  hipMemsetAsync(p.bar, 0, (size_t)(XCD_BAR_WORDS + 64) * 4, stream);
#if ONE_LAUNCH
  p.phase_begin = 0;
  p.phase_end = NPHASE;
  void* args[] = {&p};
  hipError_t e = hipLaunchCooperativeKernel((void*)mega, dim3(grid_blocks), dim3(256), args, DYN_LDS, stream);
  if (e != hipSuccess) fprintf(stderr, "cooperative launch failed: %s (grid %d)\n", hipGetErrorString(e), grid_blocks);
#else
  for (int ph = 0; ph < NPHASE; ++ph) {
    p.phase_begin = ph;
    p.phase_end = ph + 1;
    hipLaunchKernelGGL(mega, dim3(grid_blocks), dim3(256), DYN_LDS, stream, p);
  }
#endif
}
```
